# Optimizing an MI355X kernel written in HIP

```python
import math
import jax
import jax.numpy as jnp
from jax import lax
import numpy as np

D_MODEL = 2048
BATCH = 2
SEQ = 4096
DEPTH = 2

CHUNK = 64
EPS = 1e-6
MIX_WIDTH = D_MODEL
GROUP_WIDTH = MIX_WIDTH // 2

RET_HEADS = 4
RET_DK = GROUP_WIDTH // RET_HEADS
RET_DV = GROUP_WIDTH // RET_HEADS
ROPE_BASE = 10000.0
SGU_WINDOW = 128
SGU_GROUPS = 4
SGU_DG = GROUP_WIDTH // SGU_GROUPS
HG_HEADS = 8
HG_DK = GROUP_WIDTH // HG_HEADS
HG_DV = GROUP_WIDTH // HG_HEADS
DSA_HEADS = 8
DSA_DV = GROUP_WIDTH // DSA_HEADS
DSA_Q_RANK = 384
DSA_KV_RANK = 256
IDX_HEADS = 16
IDX_DIM = 64
TOPK_MAX = 256
Q_BLOCK = 128
REL_BUCKETS = 32
REL_MAX_DIST = 256
D_FF = ((-(-8 * D_MODEL // 3)) + 255) // 256 * 256

EVEN_IN = 4 * GROUP_WIDTH + 2 * GROUP_WIDTH
ODD_IN = 4 * GROUP_WIDTH + DSA_Q_RANK + DSA_KV_RANK + IDX_DIM + IDX_HEADS

kernel_name = "hybrid_retention_sgu_hgrn2_dsa_trunk"

F32 = jnp.float32


def rms_norm(x, g=None):
    xf = x.astype(F32)
    y = xf * lax.rsqrt(jnp.mean(xf * xf, axis=-1, keepdims=True) + EPS)
    if g is not None:
        y = y * g.astype(F32)
    return y.astype(x.dtype)


def layer_norm(x, g, b):
    xf = x.astype(F32)
    mu = jnp.mean(xf, axis=-1, keepdims=True)
    var = jnp.mean(jnp.square(xf - mu), axis=-1, keepdims=True)
    return ((xf - mu) * lax.rsqrt(var + EPS) * g.astype(F32) + b.astype(F32)).astype(x.dtype)


def rotary(x, pos):
    d = x.shape[-1]
    inv = ROPE_BASE ** (-jnp.arange(0, d, 2, dtype=F32) / d)
    ang = pos.astype(F32)[:, None] * inv[None, :]
    cos = jnp.cos(ang)[None, :, None, :]
    sin = jnp.sin(ang)[None, :, None, :]
    xf = x.astype(F32)
    x1, x2 = xf[..., : d // 2], xf[..., d // 2:]
    return jnp.concatenate([x1 * cos - x2 * sin, x1 * sin + x2 * cos], axis=-1)


def to_chunks(t, nc):
    b, s, h, d = t.shape
    return t.astype(F32).reshape(b, nc, CHUNK, h, d).transpose(1, 0, 3, 2, 4)


def from_chunks(t):
    nc, b, h, c, d = t.shape
    return t.transpose(1, 0, 3, 2, 4).reshape(b, nc * c, h, d)


def retention(q, k, v):
    b, s, h, dk = q.shape
    nc = s // CHUNK
    log_gamma = jnp.log(1.0 - 2.0 ** (-5.0 - jnp.arange(h, dtype=F32)))
    qc = to_chunks(q, nc)
    kc = to_chunks(k * (dk ** -0.5), nc)
    vc = to_chunks(v, nc)
    pos = jnp.arange(CHUNK, dtype=F32)
    d_intra = jnp.exp(log_gamma[:, None, None] * jnp.abs(pos[:, None] - pos[None, :]))
    scores = jnp.einsum('nbhid,nbhjd->nbhij', qc, kc) * d_intra[None, None]
    intra = jnp.einsum('nbhij,nbhje->nbhie', scores, vc)
    xi = jnp.exp(log_gamma[:, None] * (pos + 1.0))[None, :, :, None]
    zeta = jnp.exp(log_gamma[:, None] * (CHUNK - 1.0 - pos))[None, :, :, None]
    g_chunk = jnp.exp(log_gamma * CHUNK)[None, :, None, None]

    def step(state, inp):
        qi, ki, vi = inp
        cross = jnp.einsum('bhid,bhde->bhie', qi, state) * xi
        state = state * g_chunk + jnp.einsum('bhjd,bhje->bhde', ki * zeta, vi)
        return state, cross

    s0 = jnp.zeros((b, h, dk, v.shape[-1]), F32)
    _, cross = lax.scan(step, s0, (qc, kc, vc))
    return from_chunks(intra + cross)


def spatial_gating(u, v, ln_g, ln_b, w_s, b_s):
    b, s, _ = v.shape
    v = layer_norm(v, ln_g, ln_b).astype(F32)
    ch = jnp.arange(SGU_WINDOW) // CHUNK
    mask = ch[None, :] <= ch[:, None]
    w = jnp.where(mask[None], w_s.astype(F32), 0.0)
    vw = v.reshape(b, s // SGU_WINDOW, SGU_WINDOW, SGU_GROUPS, SGU_DG)
    mixed = jnp.einsum('gij,bnjgc->bnigc', w, vw) + b_s.astype(F32).T[None, None, :, :, None]
    return u.astype(F32) * mixed.reshape(b, s, GROUP_WIDTH)


def hgrn2(q, f_logits, i, lower_bound):
    b, s, h, dk = q.shape
    nc = s // CHUNK
    lb = lower_bound.astype(F32).reshape(h, dk)
    f = lb + (1.0 - lb) * jax.nn.sigmoid(f_logits.astype(F32))
    log_f = jnp.log(f)
    k = 1.0 - f
    qa = jax.nn.silu(q.astype(F32))
    qc, kc, lfc, vc = to_chunks(qa, nc), to_chunks(k, nc), to_chunks(log_f, nc), to_chunks(i, nc)
    causal = jnp.tril(jnp.ones((CHUNK, CHUNK), dtype=bool))

    def step(state, inp):
        qi, ki, lfi, vi = inp
        bcum = jnp.cumsum(lfi, axis=2)
        diff = bcum[:, :, :, None, :] - bcum[:, :, None, :, :]
        decay = jnp.exp(jnp.where(causal[:, :, None], diff, -jnp.inf))
        attn = jnp.einsum('bhtd,bhsd,bhtsd->bhts', qi, ki, decay)
        intra = jnp.einsum('bhts,bhse->bhte', attn, vi)
        cross = jnp.einsum('bhtd,bhde->bhte', qi * jnp.exp(bcum), state)
        blast = bcum[:, :, -1, :]
        state = state * jnp.exp(blast)[..., None] + jnp.einsum(
            'bhsd,bhse->bhde', ki * jnp.exp(blast[:, :, None, :] - bcum), vi)
        return state, intra + cross

    s0 = jnp.zeros((b, h, dk, i.shape[-1]), F32)
    _, out = lax.scan(step, s0, (qc, kc, lfc, vc))
    return from_chunks(out)


def rel_bucket(rel):
    nb = REL_BUCKETS // 2
    max_exact = nb // 2
    ret = jnp.where(rel > 0, nb, 0)
    n = jnp.abs(rel)
    nf = jnp.maximum(n, 1).astype(F32)
    large = max_exact + (jnp.log(nf / max_exact) / math.log(REL_MAX_DIST / max_exact)
                         * (nb - max_exact)).astype(jnp.int32)
    large = jnp.minimum(large, nb - 1)
    return ret + jnp.where(n < max_exact, n, large)


def dsa_attention(c_q, c_kv, k_idx, w_idx, cq_g, ckv_g, w_uq, qn_g, w_qidx, w_uv, rel_bias):
    b, s, _ = c_q.shape
    n_blk = s // Q_BLOCK
    k_sel = min(TOPK_MAX, s // 4)
    cq = rms_norm(c_q, cq_g).astype(F32)
    q = (cq @ w_uq.astype(F32)).reshape(b, s, DSA_HEADS, DSA_KV_RANK)
    q = rms_norm(q, qn_g)
    kv = rms_norm(c_kv, ckv_g).astype(F32)
    q_idx = (cq @ w_qidx.astype(F32)).reshape(b, s, IDX_HEADS, IDX_DIM)
    kix = k_idx.astype(F32)
    w_h = w_idx.astype(F32) * (IDX_HEADS ** -0.5)
    key_chunk = jnp.arange(s, dtype=jnp.int32) // CHUNK

    def blocks(t):
        return t.reshape((b, n_blk, Q_BLOCK) + t.shape[2:]).swapaxes(0, 1)

    def one_block(inp):
        qb, qib, wb, blk = inp
        t = blk * Q_BLOCK + jnp.arange(Q_BLOCK, dtype=jnp.int32)
        sc = jnp.einsum('bqhd,bsd->bqhs', qib, kix) * (IDX_DIM ** -0.5)
        sc = jnp.einsum('bqh,bqhs->bqs', wb, jax.nn.relu(sc))
        admissible = key_chunk[None, :] <= (t // CHUNK)[:, None]
        sc = jnp.where(admissible[None], sc, -jnp.inf)
        _, idx = lax.top_k(sc, k_sel)
        valid = (idx // CHUNK) <= (t // CHUNK)[None, :, None]
        kv_sel = jnp.take_along_axis(kv, idx.reshape(b, -1)[..., None], axis=1)
        kv_sel = kv_sel.reshape(b, Q_BLOCK, k_sel, DSA_KV_RANK)
        logits = jnp.einsum('bqhr,bqkr->bqhk', qb.astype(F32), kv_sel) * (DSA_KV_RANK ** -0.5)
        bias = rel_bias.astype(F32)[rel_bucket(idx - t[None, :, None])]
        logits = logits + bias.transpose(0, 1, 3, 2)
        logits = jnp.where(valid[:, :, None, :], logits, -jnp.inf)
        p = jax.nn.softmax(logits, axis=-1)
        return jnp.einsum('bqhk,bqkr->bqhr', p, kv_sel)

    o = lax.map(one_block, (blocks(q), blocks(q_idx), blocks(w_h), jnp.arange(n_blk, dtype=jnp.int32)))
    o = o.swapaxes(0, 1).reshape(b, s, DSA_HEADS, DSA_KV_RANK)
    return jnp.einsum('bshr,hrd->bshd', o, w_uv.astype(F32)).reshape(b, s, GROUP_WIDTH)


def even_mixer(h, pos, w_in, w_out, sgu_ln_g, sgu_ln_b, sgu_w_s, sgu_b_s):
    b, s, _ = h.shape
    z = h @ w_in
    q, k, v, g, u, vs = jnp.split(z, 6, axis=-1)
    q = rotary(q.reshape(b, s, RET_HEADS, RET_DK), pos)
    k = rotary(k.reshape(b, s, RET_HEADS, RET_DK), pos)
    ret = retention(q, k, v.reshape(b, s, RET_HEADS, RET_DV))
    ret = rms_norm(ret).reshape(b, s, GROUP_WIDTH) * jax.nn.silu(g.astype(F32))
    sgu = spatial_gating(jax.nn.gelu(u, approximate=False), jax.nn.gelu(vs, approximate=False),
                         sgu_ln_g, sgu_ln_b, sgu_w_s, sgu_b_s)
    mixed = jnp.concatenate([ret.astype(h.dtype), sgu.astype(h.dtype)], axis=-1)
    return mixed @ w_out


def odd_mixer(h, lb, w_in, w_out, hgrn_norm_g, cq_g, ckv_g, w_uq, qn_g, w_qidx, w_uv, rel_bias):
    b, s, _ = h.shape
    z = h @ w_in
    offs = [int(o) for o in np.cumsum([GROUP_WIDTH] * 4 + [DSA_Q_RANK, DSA_KV_RANK, IDX_DIM])]
    hq, hf, hi, hg, c_q, c_kv, k_idx, w_idx = jnp.split(z, offs, axis=-1)
    hg_out = hgrn2(hq.reshape(b, s, HG_HEADS, HG_DK), hf.reshape(b, s, HG_HEADS, HG_DK),
                   hi.reshape(b, s, HG_HEADS, HG_DV), lb)
    hg_out = rms_norm(hg_out, hgrn_norm_g.reshape(HG_HEADS, HG_DV)).reshape(b, s, GROUP_WIDTH)
    hg_out = hg_out * jax.nn.silu(hg.astype(F32))
    attn = dsa_attention(c_q, c_kv, k_idx, w_idx, cq_g, ckv_g, w_uq, qn_g, w_qidx, w_uv, rel_bias)
    mixed = jnp.concatenate([hg_out.astype(h.dtype), attn.astype(h.dtype)], axis=-1)
    return mixed @ w_out


def swiglu(h, wg, wu, wd):
    return (jax.nn.silu(h @ wg) * (h @ wu)) @ wd


def setup_inputs(seed: int = 0) -> dict:
    key = jax.random.key(seed)
    ks = iter(jax.random.split(key, 32))
    n_even = (DEPTH + 1) // 2
    n_odd = DEPTH // 2

    def nrm(shape, scale):
        return jax.random.normal(next(ks), shape, F32) * scale

    def gain(shape):
        return 1.0 + 0.01 * jax.random.normal(next(ks), shape, F32)

    return {
        "x": nrm((BATCH, SEQ, D_MODEL), 1.0),
        "ln_mix_g": gain((DEPTH, D_MODEL)),
        "ln_ffn_g": gain((DEPTH, D_MODEL)),
        "w_ffn_gate": nrm((DEPTH, D_MODEL, D_FF), D_MODEL ** -0.5),
        "w_ffn_up": nrm((DEPTH, D_MODEL, D_FF), D_MODEL ** -0.5),
        "w_ffn_down": nrm((DEPTH, D_FF, D_MODEL), D_FF ** -0.5),
        "rel_bias": nrm((REL_BUCKETS, DSA_HEADS), 0.2),
        "ev_w_in": nrm((n_even, D_MODEL, EVEN_IN), D_MODEL ** -0.5),
        "ev_w_out": nrm((n_even, MIX_WIDTH, D_MODEL), MIX_WIDTH ** -0.5),
        "sgu_ln_g": gain((n_even, GROUP_WIDTH)),
        "sgu_ln_b": nrm((n_even, GROUP_WIDTH), 0.01),
        "sgu_w_s": nrm((n_even, SGU_GROUPS, SGU_WINDOW, SGU_WINDOW), SGU_WINDOW ** -0.5),
        "sgu_b_s": gain((n_even, SGU_GROUPS, SGU_WINDOW)),
        "od_w_in": nrm((n_odd, D_MODEL, ODD_IN), D_MODEL ** -0.5),
        "od_w_out": nrm((n_odd, MIX_WIDTH, D_MODEL), MIX_WIDTH ** -0.5),
        "hgrn_lb": nrm((DEPTH, GROUP_WIDTH), 0.1),
        "hgrn_norm_g": gain((n_odd, GROUP_WIDTH)),
        "dsa_cq_g": gain((n_odd, DSA_Q_RANK)),
        "dsa_ckv_g": gain((n_odd, DSA_KV_RANK)),
        "dsa_w_uq": nrm((n_odd, DSA_Q_RANK, DSA_HEADS * DSA_KV_RANK), DSA_Q_RANK ** -0.5),
        "dsa_qnorm_g": gain((n_odd, DSA_KV_RANK)),
        "dsa_w_qidx": nrm((n_odd, DSA_Q_RANK, IDX_HEADS * IDX_DIM), DSA_Q_RANK ** -0.5),
        "dsa_w_uv": nrm((n_odd, DSA_HEADS, DSA_KV_RANK, DSA_DV), DSA_KV_RANK ** -0.5),
    }


def reference(x, ln_mix_g, ln_ffn_g, w_ffn_gate, w_ffn_up, w_ffn_down, rel_bias,
              ev_w_in, ev_w_out, sgu_ln_g, sgu_ln_b, sgu_w_s, sgu_b_s,
              od_w_in, od_w_out, hgrn_lb, hgrn_norm_g, dsa_cq_g, dsa_ckv_g,
              dsa_w_uq, dsa_qnorm_g, dsa_w_qidx, dsa_w_uv):
    s = x.shape[1]
    pos = jnp.arange(s, dtype=jnp.int32)
    lb_soft = jax.nn.softmax(hgrn_lb.astype(F32), axis=0)
    lb_layers = jnp.cumsum(lb_soft, axis=0) - lb_soft[0]
    for layer in range(DEPTH):
        h = rms_norm(x, ln_mix_g[layer])
        j = layer // 2
        if layer % 2 == 0:
            mix = even_mixer(h, pos, ev_w_in[j], ev_w_out[j], sgu_ln_g[j], sgu_ln_b[j],
                             sgu_w_s[j], sgu_b_s[j])
        else:
            mix = odd_mixer(h, lb_layers[layer], od_w_in[j], od_w_out[j], hgrn_norm_g[j],
                            dsa_cq_g[j], dsa_ckv_g[j], dsa_w_uq[j], dsa_qnorm_g[j],
                            dsa_w_qidx[j], dsa_w_uv[j], rel_bias)
        x = x + mix.astype(x.dtype)
        h = rms_norm(x, ln_ffn_g[layer])
        x = x + swiglu(h, w_ffn_gate[layer], w_ffn_up[layer], w_ffn_down[layer]).astype(x.dtype)
    return x
```

```cpp
#include <hip/hip_runtime.h>
#include <hip/hip_cooperative_groups.h>
#include <cstdio>
#include <cstdint>
namespace cg = cooperative_groups;

#define LAS __attribute__((address_space(3)))
typedef unsigned short bf16;
typedef short bf16x8 __attribute__((ext_vector_type(8)));
typedef float f32x2 __attribute__((ext_vector_type(2)));
typedef float f32x4 __attribute__((ext_vector_type(4)));
typedef float f32x16 __attribute__((ext_vector_type(16)));
typedef unsigned u32x2 __attribute__((ext_vector_type(2)));
typedef unsigned u32x4 __attribute__((ext_vector_type(4)));

constexpr int BATCH = 2, SEQ = 4096, DM = 2048, M = BATCH * SEQ, FF = 5632;
constexpr int EVEN_IN = 6144, ODD_IN = 4816, ODD_PAD = 4864;
constexpr float EPS = 1e-6f;
constexpr int Z1_HQ = 0, Z1_HF = 1024, Z1_HI = 2048, Z1_HGATE = 3072, Z1_CQ = 4096, Z1_CKV = 4480, Z1_KIDX = 4736, Z1_WIDX = 4800;

__device__ __forceinline__ unsigned f2bf(float f) { unsigned u = __float_as_uint(f); return (u + 0x7fffu + ((u >> 16) & 1u)) >> 16; }
typedef __bf16 bf16x2_t __attribute__((ext_vector_type(2)));
__device__ __forceinline__ unsigned pk2(float lo, float hi) { const f32x2 v = {lo, hi}; const bf16x2_t b = __builtin_convertvector(v, bf16x2_t); return __builtin_bit_cast(unsigned, b); }
__device__ __forceinline__ bf16 f2bf1(float f) { return (bf16)(pk2(f, 0.f) & 0xffffu); }
__device__ __forceinline__ float bflo(unsigned w) { return __uint_as_float(w << 16); }
__device__ __forceinline__ float bfhi(unsigned w) { return __uint_as_float(w & 0xffff0000u); }
__device__ __forceinline__ float bf2f(bf16 b) { return __uint_as_float(((unsigned)b) << 16); }
template <int CTRL> __device__ __forceinline__ float dpp_f(float x) { return __builtin_bit_cast(float, __builtin_amdgcn_update_dpp(0, __builtin_bit_cast(int, x), CTRL, 0xF, 0xF, true)); }
__device__ __forceinline__ float row_sum8(float x) { x += dpp_f<0xB1>(x); x += dpp_f<0x4E>(x); x += dpp_f<0x141>(x); return x; }
__device__ __forceinline__ float row_sum16(float x) { x = row_sum8(x); x += dpp_f<0x140>(x); return x; }
__device__ __forceinline__ float row_max16(float x) { x = fmaxf(x, dpp_f<0xB1>(x)); x = fmaxf(x, dpp_f<0x4E>(x)); x = fmaxf(x, dpp_f<0x141>(x)); x = fmaxf(x, dpp_f<0x140>(x)); return x; }
__device__ __forceinline__ float rdlane(float x, int l) { return __builtin_bit_cast(float, __builtin_amdgcn_readlane(__builtin_bit_cast(int, x), l)); }
__device__ __forceinline__ float wave_sum(float v) { v = row_sum16(v); return (rdlane(v, 0) + rdlane(v, 16)) + (rdlane(v, 32) + rdlane(v, 48)); }
__device__ __forceinline__ float wave_max(float v) { v = row_max16(v); return fmaxf(fmaxf(rdlane(v, 0), rdlane(v, 16)), fmaxf(rdlane(v, 32), rdlane(v, 48))); }
__device__ __forceinline__ float sigmoidf_(float x) { return 1.0f / (1.0f + __expf(-x)); }
__device__ __forceinline__ float siluf_(float x) { return x / (1.0f + __expf(-x)); }
#define LDS_WAIT() asm volatile("s_waitcnt lgkmcnt(0)" ::: "memory")
#define LDS_BAR() do { asm volatile("s_waitcnt lgkmcnt(0)" ::: "memory"); __builtin_amdgcn_s_barrier(); asm volatile("" ::: "memory"); } while (0)

#ifndef PG8_WGM
#define PG8_WGM 2
#endif
namespace pg8 {
constexpr int BM = 256, BK = 64, HALF = 128, HTB = HALF * BK * 2  , STAGE_BYTES = 8 * HTB, NXCD = 8, WGM = PG8_WGM;

__host__ __device__ __forceinline__ int lds_byte(int r, int c) { const int st = (r >> 4) * 2 + (c >> 5), rr = r & 15, cc = c & 31, ob = rr * 64 + cc * 2; return st * 1024 + (ob ^ (((ob >> 9) & 1) << 5)); }
__host__ __device__ __forceinline__ void stage_rc(int b, int& R, int& C) { const int st = b / 1024, sb = b % 1024, swz = sb ^ (((sb >> 9) & 1) << 5); R = (st >> 1) * 16 + swz / 64; C = (st & 1) * 32 + (swz % 64) / 2; }
__host__ __device__ __forceinline__ int perm32(int rho) { const int n = rho >> 4, i = rho & 15; return 8 * (i >> 2) + 4 * n + (i & 3); }

struct Unit { int pm, pn, half; };
struct Gemm { const bf16* A; const bf16* Bt; int M, N, K, lda, ldb; };

struct StaticOrder {
    int nM, nN, nwg, G, c, wgm;
    __host__ __device__ void init(int M_, int N_, int G_, int c_, int wgm_ = WGM) { nM = M_ / BM; nN = N_ / BM; nwg = nM * nN; G = G_; c = c_; wgm = wgm_; }
    __host__ __device__ bool next(int i, Unit& u) const {
        if (c < 0) return false;
        const int base = i * G, rem = nwg - base; if (rem <= 0) return false;
        long L; u.half = -1;
        if (rem >= G || 2 * rem > G) { L = (long)base + c; if (L >= nwg) return false; }
        else { if (c >= 2 * rem) return false; L = (long)base + (c >> 1); u.half = c & 1; }
        int wgid = (int)L;
#ifndef PG8_NO_XCD_REMAP
        { const int q = nwg / NXCD, r = nwg % NXCD, xcd = wgid % NXCD, off = wgid / NXCD; wgid = (xcd < r ? xcd * (q + 1) : r * (q + 1) + (xcd - r) * q) + off; }
#endif
        const int nig = wgm * nN, gid = wgid / nig, fm = gid * wgm, gsz = (nM - fm) < wgm ? (nM - fm) : wgm;
        u.pm = fm + ((wgid % nig) % gsz); u.pn = (wgid % nig) / gsz; return true;
    }
};

__device__ __forceinline__ unsigned cvt_pk_bf16(float lo, float hi) { return pk2(lo, hi); }
__device__ __forceinline__ f32x2 gelu_pk(f32x2 v) {
    const f32x2 av = __builtin_elementwise_abs(v), d = av * 0.2316418882f + 1.0f;
    f32x2 t; t.x = __builtin_amdgcn_rcpf(d.x); t.y = __builtin_amdgcn_rcpf(d.y);
    f32x2 q = t * 0.5307027145f + (-0.7265760135f); q = q * t + 0.7107068705f; q = q * t + (-0.142248368f); q = q * t + 0.127414796f; q = q * t;
    const f32x2 s = (v * v) * (-0.72134752044f);
    f32x2 e; e.x = __builtin_amdgcn_exp2f(s.x); e.y = __builtin_amdgcn_exp2f(s.y);
    const f32x2 m = v * (q * e), r = v - m;
    f32x2 o; o.x = v.x < 0.f ? m.x : r.x; o.y = v.y < 0.f ? m.y : r.y; return o;
}

struct EpiBf16 {
    static constexpr bool PERM = true;
    bf16* O0; int ld0; bf16* O1; int ld1; int split_pn; int gelu_pn; const float* ssq;
    __device__ __forceinline__ void operator()(const f32x4 (&acc)[2][2][4][2], const Unit& u, int wr, int wc, int fr, int fq) const {
        const int row0 = u.pm * BM + wr * 64 + fr;
        bf16* base = O0; int ldc = ld0; int colt = u.pn * BM;
        if (u.pn >= split_pn) { base = O1; ldc = ld1; colt = (u.pn - split_pn) * BM; }
        const bool act = u.pn >= gelu_pn;
        const int col0 = colt + wc * 32 + 8 * fq;
#pragma unroll
        for (int ai = 0; ai < 2; ++ai) { if (u.half >= 0 && u.half != ai) continue;
#pragma unroll
            for (int m = 0; m < 4; ++m) { const int row = row0 + ai * HALF + m * 16; bf16* rowp = base + (size_t)row * ldc + col0;
                const float rs = ssq ? __builtin_amdgcn_rsqf(ssq[row] * (1.0f / 2048.0f) + 1e-6f) : 1.0f;
#pragma unroll
                for (int bj = 0; bj < 2; ++bj) { f32x4 v0 = acc[ai][bj][m][0] * rs, v1 = acc[ai][bj][m][1] * rs;
                    if (act) { f32x2 a = gelu_pk((f32x2){v0[0], v0[1]}), b = gelu_pk((f32x2){v0[2], v0[3]}), c = gelu_pk((f32x2){v1[0], v1[1]}), d = gelu_pk((f32x2){v1[2], v1[3]});
                        v0 = (f32x4){a.x, a.y, b.x, b.y}; v1 = (f32x4){c.x, c.y, d.x, d.y}; }
                    u32x4 w; w.x = cvt_pk_bf16(v0[0], v0[1]); w.y = cvt_pk_bf16(v0[2], v0[3]); w.z = cvt_pk_bf16(v1[0], v1[1]); w.w = cvt_pk_bf16(v1[2], v1[3]);
                    *(u32x4*)(rowp + bj * HALF) = w; } } }
    }
};
struct EpiRes {
    static constexpr bool PERM = true;
    const float* base; float* out; int ldc; bf16* xb; float* ssq;
    __device__ __forceinline__ void operator()(const f32x4 (&acc)[2][2][4][2], const Unit& u, int wr, int wc, int fr, int fq) const {
        const int row0 = u.pm * BM + wr * 64 + fr, col0 = u.pn * BM + wc * 32 + 8 * fq;
#pragma unroll
        for (int ai = 0; ai < 2; ++ai) { if (u.half >= 0 && u.half != ai) continue;
#pragma unroll
            for (int m = 0; m < 4; ++m) { const int row = row0 + ai * HALF + m * 16; const size_t off = (size_t)row * ldc + col0; float sq = 0.f;
#pragma unroll
                for (int bj = 0; bj < 2; ++bj) { const f32x4 b0 = *(const f32x4*)(base + off + bj * HALF), b1 = *(const f32x4*)(base + off + bj * HALF + 4);
                    const f32x4 v0 = b0 + acc[ai][bj][m][0], v1 = b1 + acc[ai][bj][m][1];
                    *(f32x4*)(out + off + bj * HALF) = v0; *(f32x4*)(out + off + bj * HALF + 4) = v1;
                    if (xb) { u32x4 w; w.x = cvt_pk_bf16(v0[0], v0[1]); w.y = cvt_pk_bf16(v0[2], v0[3]); w.z = cvt_pk_bf16(v1[0], v1[1]); w.w = cvt_pk_bf16(v1[2], v1[3]); *(u32x4*)(xb + off + bj * HALF) = w;
                        sq += ((v0[0] * v0[0] + v0[1] * v0[1]) + (v0[2] * v0[2] + v0[3] * v0[3])) + ((v1[0] * v1[0] + v1[1] * v1[1]) + (v1[2] * v1[2] + v1[3] * v1[3])); } }
                if (xb) { sq += __shfl_xor(sq, 16); sq += __shfl_xor(sq, 32); if (fq == 0) atomicAdd(ssq + row, sq); }
                asm volatile("" ::: "memory"); } }
    }
};
struct EpiSwiglu {
    static constexpr bool PERM = true;
    bf16* O; int ldc; const float* ssq;
    __device__ __forceinline__ void operator()(const f32x4 (&acc)[2][2][4][2], const Unit& u, int wr, int wc, int fr, int fq) const {
        const int row0 = u.pm * BM + wr * 64 + fr, col0 = u.pn * HALF + wc * 32 + 8 * fq;
#pragma unroll
        for (int ai = 0; ai < 2; ++ai) { if (u.half >= 0 && u.half != ai) continue;
#pragma unroll
            for (int m = 0; m < 4; ++m) { const int row = row0 + ai * HALF + m * 16; bf16* rowp = O + (size_t)row * ldc + col0;
                const float rs = __builtin_amdgcn_rsqf(ssq[row] * (1.0f / 2048.0f) + 1e-6f);
                float r[8];
#pragma unroll
                for (int n = 0; n < 2; ++n)
#pragma unroll
                    for (int j = 0; j < 4; ++j) { const float g = acc[ai][0][m][n][j] * rs, up = acc[ai][1][m][n][j] * rs; r[4 * n + j] = g * __builtin_amdgcn_rcpf(1.0f + __expf(-g)) * up; }
                u32x4 w; w.x = cvt_pk_bf16(r[0], r[1]); w.y = cvt_pk_bf16(r[2], r[3]); w.z = cvt_pk_bf16(r[4], r[5]); w.w = cvt_pk_bf16(r[6], r[7]);
                *(u32x4*)rowp = w; } }
    }
};

template <class Epi, bool ALIGN_EPI, bool SP2>
__device__ __forceinline__ void gemm_phase(LAS unsigned char* lds, const Gemm g, const StaticOrder& S, const Epi& E) {
    const int tid = threadIdx.x, wid = __builtin_amdgcn_readfirstlane(tid >> 6), lane = tid & 63, wr = wid >> 2, wc = wid & 3, fr = lane & 15, fq = lane >> 4;
    const int K = g.K, nt = K / BK;
    unsigned voffA[2], voffB[2];
#pragma unroll
    for (int i = 0; i < 2; ++i) { int R, C; stage_rc(tid * 16 + i * 8192, R, C); const int Rb = Epi::PERM ? ((R & ~31) + perm32(R & 31)) : R;
        voffA[i] = (unsigned)(R * g.lda + C) * 2u; voffB[i] = (unsigned)(Rb * g.ldb + C) * 2u; }
    const size_t kstep = (size_t)(BK * 2);
    const size_t hstepA = (size_t)HALF * g.lda * 2, hstepB = (size_t)HALF * g.ldb * 2;
    const size_t tstepA = 2 * hstepA, tstepB = 2 * hstepB;
    const unsigned ldsw = (unsigned)wid * 1024u;
    const int aoff = lds_byte(wr * 64 + fr, fq * 8), boff = lds_byte(wc * 32 + fr, fq * 8);
#define PG8_SA(b, h) (((b) * 2 + (h)) * HTB)
#define PG8_SB(b, h) ((4 + (b) * 2 + (h)) * HTB)
#define PG8_STAGE(bufoff, gbase, voff) do { _Pragma("unroll") for (int _i = 0; _i < 2; ++_i) \
        __builtin_amdgcn_global_load_lds((const unsigned*)((const char*)(gbase) + (voff)[_i]), (LAS unsigned*)(lds + (bufoff) + ldsw + _i * 8192), 16, 0, 0); } while (0)
#define PG8_LDA(dst, b, h) do { _Pragma("unroll") for (int m = 0; m < 4; ++m) _Pragma("unroll") for (int k = 0; k < 2; ++k) dst[m][k] = *(const LAS bf16x8*)(lds + PG8_SA(b, h) + aoff + m * 2048 + k * 1024); } while (0)
#define PG8_LDB(dst, b, h) do { _Pragma("unroll") for (int n = 0; n < 2; ++n) _Pragma("unroll") for (int k = 0; k < 2; ++k) dst[n][k] = *(const LAS bf16x8*)(lds + PG8_SB(b, h) + boff + n * 2048 + k * 1024); } while (0)
#define PG8_MMA(ai, bj, At, Bt) do { __builtin_amdgcn_s_setprio(1); _Pragma("unroll") for (int m = 0; m < 4; ++m) _Pragma("unroll") for (int n = 0; n < 2; ++n) _Pragma("unroll") for (int k = 0; k < 2; ++k) \
        acc[ai][bj][m][n] = __builtin_amdgcn_mfma_f32_16x16x32_bf16(Bt[n][k], At[m][k], acc[ai][bj][m][n], 0, 0, 0); __builtin_amdgcn_s_setprio(0); } while (0)
#define PG8_WAIT_V(n) asm volatile("s_waitcnt vmcnt(" #n ")" ::: "memory")
#define PG8_WAIT_L(n) asm volatile("s_waitcnt lgkmcnt(" #n ")" ::: "memory")
#define PG8_BAR __builtin_amdgcn_s_barrier()
#define PG8_SCHED __builtin_amdgcn_sched_barrier(0)
    Unit cur, nxt; int ui = 0;
    if (!S.next(0, cur)) return;
    f32x4 acc[2][2][4][2];
#pragma unroll
    for (int a = 0; a < 2; ++a)
#pragma unroll
        for (int b = 0; b < 2; ++b)
#pragma unroll
            for (int m = 0; m < 4; ++m)
#pragma unroll
                for (int n = 0; n < 2; ++n) acc[a][b][m][n] = (f32x4){0.f, 0.f, 0.f, 0.f};
    bf16x8 At[4][2], B0[2][2], B1[2][2];
    const char* cA = (const char*)g.A + (size_t)cur.pm * tstepA; const char* cB = (const char*)g.Bt + (size_t)cur.pn * tstepB;
    if constexpr (SP2) {
        PG8_STAGE(PG8_SB(0, 0), cB, voffB); PG8_STAGE(PG8_SB(0, 1), cB + hstepB, voffB); PG8_STAGE(PG8_SA(0, 0), cA, voffA); PG8_STAGE(PG8_SA(0, 1), cA + hstepA, voffA);
        if (wr == 1) PG8_BAR;
        PG8_WAIT_V(2); PG8_BAR;
        PG8_STAGE(PG8_SB(1, 0), cB + kstep, voffB); PG8_STAGE(PG8_SA(1, 0), cA + kstep, voffA); PG8_STAGE(PG8_SB(1, 1), cB + hstepB + kstep, voffB);
        PG8_WAIT_V(6); PG8_BAR;
    } else {
        PG8_STAGE(PG8_SB(0, 0), cB, voffB); PG8_STAGE(PG8_SA(0, 0), cA, voffA); PG8_STAGE(PG8_SB(0, 1), cB + hstepB, voffB); PG8_STAGE(PG8_SA(0, 1), cA + hstepA, voffA);
        if (wr == 1) PG8_BAR;
        PG8_WAIT_V(4); PG8_BAR;
        PG8_STAGE(PG8_SB(1, 0), cB + kstep, voffB); PG8_STAGE(PG8_SA(1, 0), cA + kstep, voffA); PG8_STAGE(PG8_SB(1, 1), cB + hstepB + kstep, voffB);
        PG8_WAIT_V(6); PG8_BAR;
    }
    for (;;) {
        const bool has_next = S.next(ui + 1, nxt);
        const char* nA = has_next ? (const char*)g.A + (size_t)nxt.pm * tstepA : cA; const char* nB = has_next ? (const char*)g.Bt + (size_t)nxt.pn * tstepB : cB;
        const int uh = cur.half;
#define PG8_MMF0(At, B0, B1) do { PG8_MMA(0, 0, At, B0); PG8_MMA(0, 1, At, B1); } while (0)
#define PG8_MMF1(At, B0, B1) do { PG8_MMA(1, 0, At, B0); PG8_MMA(1, 1, At, B1); } while (0)
#define PG8_MMN(At, B0, B1) do { } while (0)
#define PG8_KLOOP(MM0, MM1) \
        for (int t = 0; t < nt; t += 2) { \
            const bool last = (t == nt - 2); \
            const char* a1 = cA + (size_t)(t + 1) * kstep; \
            const char* a2 = last ? nA : cA + (size_t)(t + 2) * kstep; const char* b2 = last ? nB : cB + (size_t)(t + 2) * kstep; \
            const char* a3 = a2 + kstep; const char* b3 = b2 + kstep; \
            if constexpr (SP2) { \
            PG8_LDB(B0, 0, 0); PG8_LDB(B1, 0, 1); PG8_SCHED; PG8_LDA(At, 0, 0); PG8_STAGE(PG8_SA(1, 1), a1 + hstepA, voffA); \
            PG8_WAIT_V(8); PG8_WAIT_L(0); PG8_BAR; MM0(At, B0, B1); PG8_BAR; PG8_SCHED; \
            PG8_LDA(At, 0, 1); PG8_STAGE(PG8_SB(0, 0), b2, voffB); PG8_STAGE(PG8_SB(0, 1), b2 + hstepB, voffB); PG8_STAGE(PG8_SA(0, 0), a2, voffA); \
            PG8_WAIT_V(8); PG8_WAIT_L(0); PG8_BAR; MM1(At, B0, B1); PG8_BAR; PG8_SCHED; \
            PG8_LDB(B0, 1, 0); PG8_LDB(B1, 1, 1); PG8_SCHED; PG8_LDA(At, 1, 0); PG8_STAGE(PG8_SA(0, 1), a2 + hstepA, voffA); \
            PG8_WAIT_V(8); PG8_WAIT_L(0); PG8_BAR; MM0(At, B0, B1); PG8_BAR; PG8_SCHED; \
            PG8_LDA(At, 1, 1); PG8_STAGE(PG8_SB(1, 0), b3, voffB); PG8_STAGE(PG8_SB(1, 1), b3 + hstepB, voffB); PG8_STAGE(PG8_SA(1, 0), a3, voffA); \
            PG8_WAIT_V(8); PG8_WAIT_L(0); PG8_BAR; MM1(At, B0, B1); PG8_BAR; PG8_SCHED; \
            } else { \
            PG8_LDB(B0, 0, 0); PG8_SCHED; PG8_LDA(At, 0, 0); PG8_STAGE(PG8_SA(1, 1), a1 + hstepA, voffA); \
            PG8_WAIT_L(8); PG8_BAR; PG8_WAIT_L(0); PG8_MMA(0, 0, At, B0); PG8_BAR; PG8_SCHED; \
            PG8_LDB(B1, 0, 1); PG8_STAGE(PG8_SB(0, 0), b2, voffB); \
            PG8_BAR; PG8_WAIT_L(0); PG8_MMA(0, 1, At, B1); PG8_BAR; \
            PG8_LDA(At, 0, 1); PG8_STAGE(PG8_SA(0, 0), a2, voffA); \
            PG8_BAR; PG8_WAIT_L(0); PG8_MMA(1, 0, At, B0); PG8_BAR; PG8_SCHED; \
            PG8_STAGE(PG8_SB(0, 1), b2 + hstepB, voffB); \
            PG8_WAIT_V(6); PG8_BAR; PG8_MMA(1, 1, At, B1); PG8_BAR; \
            PG8_LDB(B0, 1, 0); PG8_SCHED; PG8_LDA(At, 1, 0); PG8_STAGE(PG8_SA(0, 1), a2 + hstepA, voffA); \
            PG8_WAIT_L(8); PG8_BAR; PG8_WAIT_L(0); PG8_MMA(0, 0, At, B0); PG8_BAR; PG8_SCHED; \
            PG8_LDB(B1, 1, 1); PG8_STAGE(PG8_SB(1, 0), b3, voffB); \
            PG8_BAR; PG8_WAIT_L(0); PG8_MMA(0, 1, At, B1); PG8_BAR; \
            PG8_LDA(At, 1, 1); PG8_STAGE(PG8_SA(1, 0), a3, voffA); \
            PG8_BAR; PG8_WAIT_L(0); PG8_MMA(1, 0, At, B0); PG8_BAR; PG8_SCHED; \
            PG8_STAGE(PG8_SB(1, 1), b3 + hstepB, voffB); \
            PG8_WAIT_V(6); PG8_BAR; PG8_MMA(1, 1, At, B1); PG8_BAR; \
            } \
        }
        if (uh < 0) { PG8_KLOOP(PG8_MMF0, PG8_MMF1) } else if (uh == 0) { PG8_KLOOP(PG8_MMF0, PG8_MMN) } else { PG8_KLOOP(PG8_MMN, PG8_MMF1) }
#undef PG8_KLOOP
#undef PG8_MMF0
#undef PG8_MMF1
#undef PG8_MMN
        if constexpr (ALIGN_EPI) { if (wr == 0) PG8_BAR; }
        E(acc, cur, wr, wc, fr, fq);
        if (!has_next) break;
#pragma unroll
        for (int a = 0; a < 2; ++a)
#pragma unroll
            for (int b = 0; b < 2; ++b)
#pragma unroll
                for (int m = 0; m < 4; ++m)
#pragma unroll
                    for (int n = 0; n < 2; ++n) acc[a][b][m][n] = (f32x4){0.f, 0.f, 0.f, 0.f};
        cur = nxt; cA = nA; cB = nB; ++ui;
        if constexpr (ALIGN_EPI) { if (wr == 1) PG8_BAR; }
    }
    PG8_WAIT_V(0);
    if constexpr (!ALIGN_EPI) { if (wr == 0) PG8_BAR; }
    PG8_BAR;
#undef PG8_SA
#undef PG8_SB
#undef PG8_STAGE
#undef PG8_LDA
#undef PG8_LDB
#undef PG8_MMA
#undef PG8_WAIT_V
#undef PG8_WAIT_L
#undef PG8_BAR
#undef PG8_SCHED
}
}

constexpr size_t SZ_WIN0 = (size_t)EVEN_IN * DM * 2, SZ_WOUT0 = (size_t)DM * DM * 2, SZ_WGU = (size_t)2 * FF * DM * 2, SZ_WD = (size_t)DM * FF * 2;
constexpr size_t SZ_WIN1 = (size_t)ODD_PAD * DM * 2, SZ_WOUT1 = (size_t)DM * DM * 2, SZ_WDSA = (size_t)3072 * 384 * 2, SZ_WUVT = (size_t)8 * 128 * 256 * 2;
constexpr size_t WS_CTL = 0, CTL_BYTES = 1u << 20, WS_BAR = WS_CTL + 896 * 1024, BAR_BYTES = 16384, WS_SSQ = WS_CTL + 512 * 1024, WS_QCNT = WS_CTL + 640 * 1024;
constexpr size_t WS_WIN1 = WS_CTL + CTL_BYTES, WS_WOUT1 = WS_WIN1 + SZ_WIN1, WS_WGU1 = WS_WOUT1 + SZ_WOUT1, WS_WD1 = WS_WGU1 + SZ_WGU, WS_WDSA = WS_WD1 + SZ_WD;
constexpr size_t WS_WUVT = WS_WDSA + SZ_WDSA;
constexpr size_t WS_B = WS_WUVT + SZ_WUVT;
constexpr size_t WS_WIN0 = WS_B, WS_WOUT0 = WS_WIN0 + SZ_WIN0, WS_WGU0 = WS_WOUT0 + SZ_WOUT0, WS_WD0 = WS_WGU0 + SZ_WGU, WS_B_END = WS_WD0 + SZ_WD;
constexpr size_t WS_MIX1 = WS_B, WS_QRAW = WS_MIX1 + (size_t)M * 2048 * 2, WS_QI = WS_QRAW + (size_t)M * 2048 * 2;
static_assert(WS_QI + (size_t)M * 1024 * 2 <= WS_B_END, "layer-1 overlay fits in the layer-0 weight region");
constexpr size_t WS_XN = WS_B_END;
constexpr size_t WS_Z = WS_XN + (size_t)M * DM * 2;
constexpr size_t WS_X1 = WS_Z + (size_t)M * EVEN_IN * 2;
constexpr size_t WS_RAW = WS_X1 + (size_t)M * DM * 4;
constexpr size_t WS_MIX0 = WS_RAW + (size_t)M * 1024 * 2;
constexpr size_t WS_KVN = WS_MIX0, WS_SEL = WS_KVN + (size_t)M * 256 * 2, WS_NSEL = WS_SEL + (size_t)M * 256 * 2, WS_MSCQ = WS_NSEL + (size_t)M * 4;
constexpr size_t WS_ROPE = WS_MIX0 + (size_t)M * DM * 2;
constexpr size_t WS_END = WS_ROPE + (size_t)2 * SEQ * 128 * 4;
static_assert(WS_MSCQ + (size_t)M * 4 <= WS_ROPE, "layer-1 small buffers fit in MIX0");
static_assert(WS_END <= 473360896ull, "workspace map exceeds the guaranteed d_ws size");

constexpr int LDS_BYTES = 163840;
constexpr int NPHASES = 17;

struct Args {
    const float* in[23];
    float* out; unsigned char* ws;
    int ph_lo, ph_hi, flags, pad;
};
enum { I_X = 0, I_LN_MIX, I_LN_FFN, I_WG, I_WU, I_WD, I_RELB, I_EV_WIN, I_EV_WOUT, I_SGU_LNG, I_SGU_LNB, I_SGU_WS, I_SGU_BS, I_OD_WIN, I_OD_WOUT, I_HG_LB, I_HG_NG,
       I_CQ_G, I_CKV_G, I_W_UQ, I_QN_G, I_W_QIDX, I_W_UV };

__device__ __forceinline__ f32x4 mma_tile(const LAS bf16* A, int lda, const LAS bf16* B, int ldb, int ksteps, f32x4 acc, int r, int g) {
    const LAS bf16* pa = A + r * lda + g * 8; const LAS bf16* pb = B + r * ldb + g * 8;
    for (int s = 0; s < ksteps; ++s) {
        const bf16x8 a = *(const LAS bf16x8*)(pa + s * 32); const bf16x8 b = *(const LAS bf16x8*)(pb + s * 32);
        acc = __builtin_amdgcn_mfma_f32_16x16x32_bf16(a, b, acc, 0, 0, 0);
    }
    return acc;
}


#define XB_TMO      128
#define XB_XCNT(j)  (256  + 64 * (j))
#define XB_XSUB(j)  (1280 + 64 * (j))
#define XB_XGEN(j)  (2304 + 64 * (j))
#define XB_TOP      3328
#define XB_TOPGEN   3392
#define XCD_BAR_WORDS 3456
#define XB_SPIN_CAP (1u << 20)
__device__ __forceinline__ unsigned xb_ld(unsigned* p)              { return __hip_atomic_load(p, __ATOMIC_RELAXED, __HIP_MEMORY_SCOPE_AGENT); }
__device__ __forceinline__ unsigned xb_add(unsigned* p, unsigned v) { return __hip_atomic_fetch_add(p, v, __ATOMIC_RELAXED, __HIP_MEMORY_SCOPE_AGENT); }
__device__ __forceinline__ unsigned xb_xcc_id() { return (unsigned)__builtin_amdgcn_s_getreg((3 << 11) | 20) & 0xFu; }
#define XB_SPIN(cond, bar) do { unsigned _sp = 0; while (cond) { __builtin_amdgcn_s_sleep(1); \
    if ((++_sp & 255u) == 0u) { if (xb_ld(&(bar)[XB_TMO])) break; if (_sp > XB_SPIN_CAP) { atomicAdd(&(bar)[XB_TMO], 1u); break; } } } } while (0)
struct XcdBarrier { unsigned* bar; unsigned x; volatile LAS unsigned* st; };
__device__ __forceinline__ XcdBarrier xcd_barrier_post(unsigned* bar, volatile LAS unsigned* st) {
    XcdBarrier b; b.bar = bar; b.x = xb_xcc_id(); b.st = st;
    if (threadIdx.x == 0) (void)xb_add(&bar[XB_XCNT(b.x)], 1u);
    return b;
}
__device__ __forceinline__ void xcd_barrier_complete(unsigned* bar, unsigned x, unsigned& nloc, unsigned& nx) {
    const unsigned G = gridDim.x * gridDim.y * gridDim.z;
    unsigned sum, cnt, mine, sp = 0u;
    for (;;) {
        sum = 0u; cnt = 0u; mine = 0u;
#pragma unroll
        for (unsigned j = 0; j < 16; ++j) { const unsigned c = xb_ld(&bar[XB_XCNT(j)]); sum += c; cnt += (c > 0u) ? 1u : 0u; mine = (j == x) ? c : mine; }
        if (sum == G) break;
        __builtin_amdgcn_s_sleep(1);
        if ((++sp & 255u) == 0u) { if (xb_ld(&bar[XB_TMO])) break; if (sp > XB_SPIN_CAP) { atomicAdd(&bar[XB_TMO], 1u); break; } }
    }
    nloc = mine > 0u ? mine : 1u; nx = cnt > 0u ? cnt : 1u;
}
__device__ __forceinline__ void xcd_barrier(const XcdBarrier& b) {
    asm volatile("s_waitcnt vmcnt(0)" ::: "memory");
    __syncthreads();
    if (threadIdx.x == 0) {
        unsigned* bar = b.bar;
        __builtin_amdgcn_s_waitcnt(0);
        unsigned nloc = b.st[0], nx = b.st[1];
        if (nloc == 0u) { xcd_barrier_complete(bar, b.x, nloc, nx); b.st[0] = nloc; b.st[1] = nx; }
        const unsigned old = xb_add(&bar[XB_XSUB(b.x)], 1u);
        const unsigned gen = old / nloc;
        if (old + 1u == (gen + 1u) * nloc) {
            __builtin_amdgcn_fence(__ATOMIC_RELEASE, "agent");
            asm volatile("s_waitcnt vmcnt(0)" ::: "memory");
            const unsigned og = xb_add(&bar[XB_TOP], 1u);
            const unsigned tg = og / nx;
            if (og + 1u == (tg + 1u) * nx) xb_add(&bar[XB_TOPGEN], 1u);
            else XB_SPIN(xb_ld(&bar[XB_TOPGEN]) == tg, bar);
            __builtin_amdgcn_fence(__ATOMIC_ACQUIRE, "agent");
            xb_add(&bar[XB_XGEN(b.x)], 1u);
            asm volatile("s_waitcnt vmcnt(0)" ::: "memory");
        } else {
            XB_SPIN(xb_ld(&bar[XB_XGEN(b.x)]) == gen, bar);
            __builtin_amdgcn_fence(__ATOMIC_ACQUIRE, "agent");
            asm volatile("s_waitcnt vmcnt(0)" ::: "memory");
        }
    }
    __syncthreads();
}

struct TrD { const float* W; const float* ks; bf16* WT; int N, ldd, row_off, mode, k0, n0; };
__device__ __forceinline__ void tr_set(TrD& d, const float* W, int N, bf16* WT, int ldd, int row_off, int mode, const float* ks, int item) {
    const int nblk = (N + 63) >> 6, kb = item / nblk, nb = item - kb * nblk;
    d.W = W; d.ks = ks; d.WT = WT; d.N = N; d.ldd = ldd; d.row_off = row_off; d.mode = mode; d.k0 = 64 * kb; d.n0 = 64 * nb;
}
__device__ __forceinline__ void tr_load(const TrD& d, f32x4 (&R)[16], int lane) {
    const int n = d.n0 + 4 * (lane & 15); const bool ok = n < d.N;
    const float* p = d.W + (size_t)(d.k0 + (lane >> 4)) * d.N + n;
#pragma unroll
    for (int i = 0; i < 16; ++i) R[i] = ok ? *(const f32x4*)(p + (size_t)(4 * i) * d.N) : (f32x4){0.f, 0.f, 0.f, 0.f};
}
__device__ __forceinline__ void tr_finish(const TrD& d, const f32x4 (&R)[16], LAS float* scr, int lane) {
#pragma unroll
    for (int i = 0; i < 16; ++i) { const int kk = 4 * i + (lane >> 4); *(LAS f32x4*)(scr + kk * 68 + 4 * (kk >> 3) + 4 * (lane & 15)) = R[i]; }
    LDS_WAIT(); asm volatile("" ::: "memory");
    const int c = lane & 7; const LAS float* s = scr + (8 * c) * 68 + 4 * c;
    f32x4 g0 = (f32x4){1.f, 1.f, 1.f, 1.f}, g1 = g0;
    if (d.ks) { g0 = *(const f32x4*)(d.ks + d.k0 + 8 * c); g1 = *(const f32x4*)(d.ks + d.k0 + 8 * c + 4); }
#pragma unroll
    for (int j = 0; j < 8; ++j) { const int nl = (lane >> 3) + 8 * j, n = d.n0 + nl;
        u32x4 o; o.x = pk2(s[0 * 68 + nl] * g0.x, s[1 * 68 + nl] * g0.y); o.y = pk2(s[2 * 68 + nl] * g0.z, s[3 * 68 + nl] * g0.w);
        o.z = pk2(s[4 * 68 + nl] * g1.x, s[5 * 68 + nl] * g1.y); o.w = pk2(s[6 * 68 + nl] * g1.z, s[7 * 68 + nl] * g1.w);
        const int mr = (d.mode == 0) ? n : (256 * (n >> 7) + (n & 127) + (d.mode == 2 ? 128 : 0));
        if (n < d.N) *(u32x4*)(d.WT + (size_t)(d.row_off + mr) * d.ldd + d.k0 + 8 * c) = o; }
    LDS_WAIT(); asm volatile("" ::: "memory");
}
__device__ __forceinline__ void rms_row_to_bf16(const float* xrow, const float* gain, bf16* orow, int lane) {
    const f32x4* xr = (const f32x4*)xrow + lane; const f32x4* gr = (const f32x4*)gain + lane;
    f32x4 v[8]; float s = 0.f;
#pragma unroll
    for (int j = 0; j < 8; ++j) { v[j] = xr[64 * j]; s += (v[j].x * v[j].x + v[j].y * v[j].y) + (v[j].z * v[j].z + v[j].w * v[j].w); }
    const float rstd = __builtin_amdgcn_rsqf(wave_sum(s) * (1.0f / DM) + EPS);
    u32x2* o8 = (u32x2*)orow + lane;
#pragma unroll
    for (int j = 0; j < 8; ++j) { const f32x4 gg = gr[64 * j]; u32x2 w; w.x = pk2(v[j].x * rstd * gg.x, v[j].y * rstd * gg.y); w.y = pk2(v[j].z * rstd * gg.z, v[j].w * rstd * gg.w); o8[64 * j] = w; }
}
__device__ __forceinline__ void norm_rows(const float* X, const float* gain, bf16* XN, int gw, int NGW, int lane) {
    asm volatile("" : "+v"(lane));
    for (int m = gw; m < M; m += NGW) rms_row_to_bf16(X + (size_t)m * DM, gain, XN + (size_t)m * DM, lane);
}


template <int SET>
__device__ __forceinline__ bool conv_desc(const Args& a, int r, TrD& d) {
    unsigned char* ws = a.ws;
    constexpr int J_IN0 = (DM / 64) * (EVEN_IN / 64), J_SQ = (DM / 64) * (DM / 64), J_GU = (DM / 64) * (FF / 64), J_DN = (FF / 64) * (DM / 64), J_IN1 = (DM / 64) * ((ODD_IN + 63) / 64),
                  J_UQ = (384 / 64) * (2048 / 64), J_QI = (384 / 64) * (1024 / 64), J_UV = 8 * (256 / 64) * (128 / 64);
    const float* wg = a.in[I_WG]; const float* wu = a.in[I_WU]; const float* wd = a.in[I_WD];
    if (r < 0) return false;
    if (SET == 0) { if (r >= J_IN0) return false; tr_set(d, a.in[I_EV_WIN], EVEN_IN, (bf16*)(ws + WS_WIN0), DM, 0, 0, nullptr, r); return true; }
    if (SET == 1) {
        if (r < J_SQ) { tr_set(d, a.in[I_EV_WOUT], DM, (bf16*)(ws + WS_WOUT0), DM, 0, 0, nullptr, r); return true; } r -= J_SQ;
        if (r < J_GU) { tr_set(d, wg, FF, (bf16*)(ws + WS_WGU0), DM, 0, 1, a.in[I_LN_FFN], r); return true; } r -= J_GU;
        if (r < J_GU) { tr_set(d, wu, FF, (bf16*)(ws + WS_WGU0), DM, 0, 2, a.in[I_LN_FFN], r); return true; } r -= J_GU;
        if (r < J_DN) { tr_set(d, wd, DM, (bf16*)(ws + WS_WD0), FF, 0, 0, nullptr, r); return true; } r -= J_DN;
        if (r < J_IN1) { tr_set(d, a.in[I_OD_WIN], ODD_IN, (bf16*)(ws + WS_WIN1), DM, 0, 0, a.in[I_LN_MIX] + DM, r); return true; } r -= J_IN1;
        if (r < J_UQ) { tr_set(d, a.in[I_W_UQ], 2048, (bf16*)(ws + WS_WDSA), 384, 0, 0, a.in[I_CQ_G], r); return true; } r -= J_UQ;
        if (r < J_QI) { tr_set(d, a.in[I_W_QIDX], 1024, (bf16*)(ws + WS_WDSA), 384, 2048, 0, a.in[I_CQ_G], r); return true; }
        return false; }
    if (SET == 3) {
        if (r < J_GU) { tr_set(d, wg + (size_t)DM * FF, FF, (bf16*)(ws + WS_WGU1), DM, 0, 1, a.in[I_LN_FFN] + DM, r); return true; } r -= J_GU;
        if (r < J_GU) { tr_set(d, wu + (size_t)DM * FF, FF, (bf16*)(ws + WS_WGU1), DM, 0, 2, a.in[I_LN_FFN] + DM, r); return true; }
        return false; }
    if (r < J_DN) { tr_set(d, wd + (size_t)FF * DM, DM, (bf16*)(ws + WS_WD1), FF, 0, 0, nullptr, r); return true; } r -= J_DN;
    if (r < J_SQ) { tr_set(d, a.in[I_OD_WOUT], DM, (bf16*)(ws + WS_WOUT1), DM, 0, 0, nullptr, r); return true; } r -= J_SQ;
    if (r < J_UV) { const int h = r >> 3; tr_set(d, a.in[I_W_UV] + (size_t)h * 256 * 128, 128, (bf16*)(ws + WS_WUVT), 256, 128 * h, 0, nullptr, r & 7); return true; }
    return false;
}
template <int SET>
__device__ __forceinline__ void conv_set(const Args& a, LAS unsigned char* lds, int tid, int lane, int wave, int gwv, int ngw, int gth, int nth) {
    LAS float* scr = (LAS float*)(lds + wave * 17920);
    asm volatile("" : "+v"(lane));
    TrD d0, d1; f32x4 R0[16], R1[16];
    int it = gwv; bool v0 = conv_desc<SET>(a, it, d0);
    if (v0) tr_load(d0, R0, lane);
    while (v0) {
        const bool v1 = conv_desc<SET>(a, it + ngw, d1);
        if (v1) tr_load(d1, R1, lane);
        tr_finish(d0, R0, scr, lane);
        if (!v1) break;
        it += 2 * ngw; v0 = conv_desc<SET>(a, it, d0);
        if (v0) tr_load(d0, R0, lane);
        tr_finish(d1, R1, scr, lane);
    }
    if (SET == 1) {
        const size_t n16 = (size_t)(ODD_PAD - ODD_IN) * DM * 2 / 16; u32x4* p = (u32x4*)((bf16*)(a.ws + WS_WIN1) + (size_t)ODD_IN * DM);
        for (size_t i = gth; i < n16; i += nth) p[i] = (u32x4){0u, 0u, 0u, 0u}; }
}
__device__ __forceinline__ void p0_prologue(const Args& a, LAS unsigned char* lds, int tid, int lane, int wave, int G) {
    unsigned char* ws = a.ws;
    const int gw = blockIdx.x * 8 + wave, NGW = G * 8;
    conv_set<0>(a, lds, tid, lane, wave, gw, NGW, blockIdx.x * 512 + tid, G * 512);
    for (int i = blockIdx.x * 512 + tid; i < 3 * M; i += G * 512) ((float*)(ws + WS_SSQ))[i] = 0.f;
    if (blockIdx.x == 0 && tid < 64) ((unsigned*)(ws + WS_QCNT))[tid] = 0u;
    { float* ct = (float*)(ws + WS_ROPE); float* st = ct + (size_t)SEQ * 128;
      for (int u = blockIdx.x * 512 + tid; u < SEQ * 128; u += G * 512) { const int t = u >> 7, i = u & 127;
          const float inv = powf(10000.0f, -(float)(2 * i) / 256.0f); const float ang = (float)t * inv; float s, c; sincosf(ang, &s, &c); ct[u] = c; st[u] = s; } }
    norm_rows(a.in[I_X], a.in[I_LN_MIX], (bf16*)(ws + WS_XN), gw, NGW, lane);
}

constexpr size_t WS_QE = WS_X1, WS_KST = WS_QE + (size_t)16 * 1024 * 1024, WS_VTT = WS_KST + (size_t)16 * 1024 * 1024, WS_INTRA = WS_VTT + (size_t)16 * 1024 * 1024, WS_DEC = WS_CTL;
constexpr size_t WS_OBUF = WS_X1;
static_assert(WS_INTRA + (size_t)M * 1024 * 2 <= WS_X1 + (size_t)M * DM * 4 && (size_t)1024 * 128 * 4 <= CTL_BYTES, "scan scratch fits in X1 / CTL");

template <int DK, bool HG>
__device__ __forceinline__ void prep_item(const Args& a, LAS unsigned char* lds, int item, int tid, int lane, int wave) {
    constexpr int DV = DK, LQ = DK + 8, LT = 72, KS = DK / 32, NH = HG ? 8 : 4;
    constexpr int O_QE = 0, O_KE = O_QE + 64 * LQ * 2, O_KST = O_KE + 64 * LQ * 2, O_VT = O_KST + DK * LT * 2, O_P = O_VT + DV * LT * 2, O_TAB = O_P + 64 * LT * 2;
    static_assert(O_TAB + 4096 <= LDS_BYTES, "prep LDS map");
    LAS bf16* Qe = (LAS bf16*)(lds + O_QE); LAS bf16* Ke = (LAS bf16*)(lds + O_KE); LAS bf16* KsT = (LAS bf16*)(lds + O_KST); LAS bf16* VT = (LAS bf16*)(lds + O_VT);
    LAS bf16* Pm = (LAS bf16*)(lds + O_P); LAS float* TAB = (LAS float*)(lds + O_TAB);
    const int r = lane & 15, g = lane >> 4;
    const int c = item & 63, bh = item >> 6, b = bh / NH, h = bh % NH;
    const bf16* Z = (const bf16*)(a.ws + WS_Z);
    const int ldz = HG ? ODD_PAD : EVEN_IN, cq = HG ? (Z1_HQ + h * 128) : (h * 256), ck = HG ? (Z1_HF + h * 128) : (1024 + h * 256), cv = HG ? (Z1_HI + h * 128) : (2048 + h * 256);
    const size_t t0 = (size_t)b * SEQ + (size_t)c * 64;
    bf16* RAW = (bf16*)(a.ws + WS_INTRA);
    if (!HG) { const float lgam = log2f(1.0f - exp2f(-5.0f - (float)h)); if (tid < 65) TAB[tid] = exp2f(lgam * (float)tid); }
#pragma unroll
    for (int k = 0; k < DV / 64; ++k) { const int eg = wave + 8 * k, i = lane; const u32x4 rv = *(const u32x4*)(Z + (t0 + i) * ldz + cv + 8 * eg);
#pragma unroll
        for (int e = 0; e < 4; ++e) { VT[(8 * eg + 2 * e) * LT + i] = (bf16)(rv[e] & 0xffffu); VT[(8 * eg + 2 * e + 1) * LT + i] = (bf16)(rv[e] >> 16); } }
    if (!HG) {
        __syncthreads();
#pragma unroll
        for (int k = 0; k < 2; ++k) { const int d0 = 8 * (wave + 8 * k), i = lane; const bf16* zr = Z + (t0 + i) * ldz;
            const u32x4 rq1 = *(const u32x4*)(zr + cq + d0), rq2 = *(const u32x4*)(zr + cq + 128 + d0), rk1 = *(const u32x4*)(zr + ck + d0), rk2 = *(const u32x4*)(zr + ck + 128 + d0);
            const float* cp = (const float*)(a.ws + WS_ROPE) + (size_t)(c * 64 + i) * 128 + d0; const float* sp = cp + (size_t)SEQ * 128;
            const f32x4 c0 = *(const f32x4*)cp, c1 = *(const f32x4*)(cp + 4), s0 = *(const f32x4*)sp, s1 = *(const f32x4*)(sp + 4);
            const float zeta = TAB[63 - i];
            float q1[8], q2[8], k1[8], k2[8], cs[8], sn[8];
#pragma unroll
            for (int e = 0; e < 4; ++e) { q1[2 * e] = bflo(rq1[e]); q1[2 * e + 1] = bfhi(rq1[e]); q2[2 * e] = bflo(rq2[e]); q2[2 * e + 1] = bfhi(rq2[e]);
                k1[2 * e] = bflo(rk1[e]); k1[2 * e + 1] = bfhi(rk1[e]); k2[2 * e] = bflo(rk2[e]); k2[2 * e + 1] = bfhi(rk2[e]);
                cs[e] = c0[e]; cs[4 + e] = c1[e]; sn[e] = s0[e]; sn[4 + e] = s1[e]; }
            float qa[8], qb[8], ka[8], kb[8];
#pragma unroll
            for (int e = 0; e < 8; ++e) { qa[e] = q1[e] * cs[e] - q2[e] * sn[e]; qb[e] = q1[e] * sn[e] + q2[e] * cs[e];
                ka[e] = (k1[e] * cs[e] - k2[e] * sn[e]) * 0.0625f; kb[e] = (k1[e] * sn[e] + k2[e] * cs[e]) * 0.0625f; }
            u32x4 w;
            w.x = pk2(qa[0], qa[1]); w.y = pk2(qa[2], qa[3]); w.z = pk2(qa[4], qa[5]); w.w = pk2(qa[6], qa[7]); *(LAS u32x4*)(Qe + i * LQ + d0) = w;
            w.x = pk2(qb[0], qb[1]); w.y = pk2(qb[2], qb[3]); w.z = pk2(qb[4], qb[5]); w.w = pk2(qb[6], qb[7]); *(LAS u32x4*)(Qe + i * LQ + 128 + d0) = w;
            w.x = pk2(ka[0], ka[1]); w.y = pk2(ka[2], ka[3]); w.z = pk2(ka[4], ka[5]); w.w = pk2(ka[6], ka[7]); *(LAS u32x4*)(Ke + i * LQ + d0) = w;
            w.x = pk2(kb[0], kb[1]); w.y = pk2(kb[2], kb[3]); w.z = pk2(kb[4], kb[5]); w.w = pk2(kb[6], kb[7]); *(LAS u32x4*)(Ke + i * LQ + 128 + d0) = w;
#pragma unroll
            for (int e = 0; e < 8; ++e) { KsT[(d0 + e) * LT + i] = f2bf1(ka[e] * zeta); KsT[(128 + d0 + e) * LT + i] = f2bf1(kb[e] * zeta); }
        }
    } else {
        const int d = tid & 127, seg = tid >> 7;
        const float l0 = a.in[I_HG_LB][h * 128 + d], l1 = a.in[I_HG_LB][1024 + h * 128 + d]; const float lb = __builtin_amdgcn_rcpf(1.0f + __expf(l0 - l1));
        unsigned rfq[16];
#pragma unroll
        for (int tt = 0; tt < 16; ++tt) { const bf16* zr = Z + (t0 + 16 * seg + tt) * ldz; rfq[tt] = (unsigned)zr[ck + d] | ((unsigned)zr[cq + d] << 16); }
        float cs[16], om[16]; float run = 0.f;
#pragma unroll
        for (int tt = 0; tt < 16; ++tt) { const float fl = bflo(rfq[tt]); const float sg = __builtin_amdgcn_rcpf(1.0f + __expf(-fl)); const float f = lb + (1.0f - lb) * sg;
            om[tt] = (1.0f - lb) * (1.0f - sg); run += __logf(f); cs[tt] = run; }
        TAB[256 + seg * 128 + d] = run;
        __syncthreads();
        float off = 0.f, tot = 0.f;
#pragma unroll
        for (int s2 = 0; s2 < 4; ++s2) { const float v = TAB[256 + s2 * 128 + d]; tot += v; if (s2 < seg) off += v; }
        if (seg == 0) TAB[d] = __expf(tot);
        float ks[16];
#pragma unroll
        for (int tt = 0; tt < 16; ++tt) { const float bc = fmaxf(off + cs[tt], -80.0f); const float qv = bfhi(rfq[tt]); const float qs = qv * __builtin_amdgcn_rcpf(1.0f + __expf(-qv));
            const int t = 16 * seg + tt;
            Qe[t * LQ + d] = f2bf1(qs * __expf(bc)); Ke[t * LQ + d] = f2bf1(om[tt] * __expf(-bc)); ks[tt] = om[tt] * __expf(fmaxf(tot, -80.0f) - bc); }
        u32x4 w;
        w.x = pk2(ks[0], ks[1]); w.y = pk2(ks[2], ks[3]); w.z = pk2(ks[4], ks[5]); w.w = pk2(ks[6], ks[7]); *(LAS u32x4*)(KsT + d * LT + 16 * seg) = w;
        w.x = pk2(ks[8], ks[9]); w.y = pk2(ks[10], ks[11]); w.z = pk2(ks[12], ks[13]); w.w = pk2(ks[14], ks[15]); *(LAS u32x4*)(KsT + d * LT + 16 * seg + 8) = w;
    }
    __syncthreads();
#pragma unroll
    for (int tt = 0; tt < 2; ++tt) { const int t = 2 * wave + tt, ti = t >> 2, tj = t & 3;
        f32x4 s = mma_tile(Ke + 16 * tj * LQ, LQ, Qe + 16 * ti * LQ, LQ, KS, (f32x4){0.f, 0.f, 0.f, 0.f}, r, g);
        const int i = 16 * ti + r;
#pragma unroll
        for (int jj = 0; jj < 4; ++jj) { const int j = 16 * tj + 4 * g + jj;
            if (!HG) { const int dd = i > j ? i - j : j - i; s[jj] *= TAB[dd]; } else { if (j > i) s[jj] = 0.f; } }
        u32x2 w; w.x = pk2(s[0], s[1]); w.y = pk2(s[2], s[3]); *(LAS u32x2*)(Pm + i * LT + 16 * tj + 4 * g) = w; }
    __syncthreads();
#pragma unroll
    for (int k = 0; k < DV / 32; ++k) { const int t = wave + 8 * k, ti = t & 3, te = t >> 2;
        const f32x4 o = mma_tile(VT + 16 * te * LT, LT, Pm + 16 * ti * LT, LT, 2, (f32x4){0.f, 0.f, 0.f, 0.f}, r, g);
        u32x2 w; w.x = pk2(o[0], o[1]); w.y = pk2(o[2], o[3]);
        *(u32x2*)(RAW + (t0 + 16 * ti + r) * 1024 + h * DV + 16 * te + 4 * g) = w; }
    { bf16* QEg = (bf16*)(a.ws + WS_QE) + (size_t)item * 64 * DK; bf16* KSTg = (bf16*)(a.ws + WS_KST) + (size_t)item * DK * 64; bf16* VTTg = (bf16*)(a.ws + WS_VTT) + (size_t)item * DV * 64;
#pragma unroll
      for (int k = 0; k < DK / 64; ++k) { const int u = tid + 512 * k; const int i = u / (DK / 8), cc = u % (DK / 8);
          *(u32x4*)(QEg + (size_t)u * 8) = *(const LAS u32x4*)(Qe + i * LQ + 8 * cc);
          const int d = u >> 3, c8 = u & 7;
          *(u32x4*)(KSTg + (size_t)u * 8) = *(const LAS u32x4*)(KsT + d * LT + 8 * c8);
          *(u32x4*)(VTTg + (size_t)u * 8) = *(const LAS u32x4*)(VT + d * LT + 8 * c8); }
      if (HG && tid < 128) ((float*)(a.ws + WS_DEC))[(size_t)item * 128 + tid] = TAB[tid]; }
    __syncthreads();
}

template <int DK, bool HG>
__device__ __forceinline__ void scan_item(const Args& a, LAS unsigned char* lds, int item, int tid, int lane, int wave) {
    constexpr int DV = DK, LQ = DK + 8, LT = 72, KS = DK / 32, DT = DK / 128, NH = HG ? 8 : 4, NSL = DV / 32, NU = DK / 64;
    constexpr int O_QE = 0, O_KST = O_QE + 64 * LQ * 2, O_VT = O_KST + DK * LT * 2, O_STB = O_VT + 32 * LT * 2, O_TAB = O_STB + 32 * LQ * 2;
    LAS bf16* Qe = (LAS bf16*)(lds + O_QE); LAS bf16* KsT = (LAS bf16*)(lds + O_KST); LAS bf16* VT = (LAS bf16*)(lds + O_VT);
    LAS bf16* STb = (LAS bf16*)(lds + O_STB); LAS float* TAB = (LAS float*)(lds + O_TAB);
    const int r = lane & 15, g = lane >> 4;
    constexpr int NBH = 64 / NSL;
    const int bh = item % NBH, sl = item / NBH, b = bh / NH, h = bh % NH;
    bf16* RAW = (bf16*)(a.ws + WS_RAW);
    const bf16* QEg = (const bf16*)(a.ws + WS_QE) + (size_t)bh * 64 * 64 * DK; const bf16* KSTg = (const bf16*)(a.ws + WS_KST) + (size_t)bh * 64 * DK * 64;
    const bf16* VTTg = (const bf16*)(a.ws + WS_VTT) + (size_t)bh * 64 * DV * 64 + (size_t)sl * 32 * 64; const float* DECg = (const float*)(a.ws + WS_DEC) + (size_t)bh * 64 * 128;
    if (!HG) { const float lgam = log2f(1.0f - exp2f(-5.0f - (float)h)); if (tid < 65) TAB[tid] = exp2f(lgam * (float)tid); }
    f32x4 st[DT][2];
#pragma unroll
    for (int dt = 0; dt < DT; ++dt) { st[dt][0] = (f32x4){0.f, 0.f, 0.f, 0.f}; st[dt][1] = (f32x4){0.f, 0.f, 0.f, 0.f}; }
    const int dbase = wave * (DK / 8), ti = wave >> 1, te = wave & 1;
    const size_t tok0 = (size_t)b * SEQ;
    bf16* outp = RAW + (tok0 + 16 * ti + r) * 1024 + h * DV + sl * 32 + 16 * te + 4 * g;
    const bf16* inp = (const bf16*)(a.ws + WS_INTRA) + (tok0 + 16 * ti + r) * 1024 + h * DV + sl * 32 + 16 * te + 4 * g;
    u32x4 rqeA[NU], rksA[NU], rvtA, rqeB[NU], rksB[NU], rvtB; u32x2 rinA, rinB; f32x4 rdecA[DT], rdecB[DT];
#define SCAN_LOAD(c_, rqe, rks, rvt, rin, rdec) do { \
        _Pragma("unroll") for (int k = 0; k < NU; ++k) { const int u = tid + 512 * k; \
            rqe[k] = *(const u32x4*)(QEg + (size_t)(c_) * 64 * DK + (size_t)u * 8); rks[k] = *(const u32x4*)(KSTg + (size_t)(c_) * DK * 64 + (size_t)u * 8); } \
        if (tid < 256) rvt = *(const u32x4*)(VTTg + (size_t)(c_) * DV * 64 + (size_t)tid * 8); \
        rin = *(const u32x2*)(inp + (size_t)(c_) * 64 * 1024); \
        if (HG) { _Pragma("unroll") for (int dt = 0; dt < DT; ++dt) rdec[dt] = *(const f32x4*)(DECg + (size_t)(c_) * 128 + dbase + 16 * dt + 4 * g); } \
    } while (0)
#define SCAN_STEP(c_, rqe, rks, rvt, rin, rdec) do { \
          \
        _Pragma("unroll") for (int k = 0; k < NU; ++k) { const int u = tid + 512 * k; const int i = u / (DK / 8), cc = u % (DK / 8); \
            *(LAS u32x4*)(Qe + i * LQ + 8 * cc) = rqe[k]; *(LAS u32x4*)(KsT + (u >> 3) * LT + 8 * (u & 7)) = rks[k]; } \
        if (tid < 256) *(LAS u32x4*)(VT + (tid >> 3) * LT + 8 * (tid & 7)) = rvt; \
        _Pragma("unroll") for (int dt = 0; dt < DT; ++dt) \
            _Pragma("unroll") for (int et = 0; et < 2; ++et) { u32x2 w; w.x = pk2(st[dt][et][0], st[dt][et][1]); w.y = pk2(st[dt][et][2], st[dt][et][3]); \
                *(LAS u32x2*)(STb + (16 * et + r) * LQ + dbase + 16 * dt + 4 * g) = w; } \
        const u32x2 inx = rin; f32x4 dec[DT]; \
        _Pragma("unroll") for (int dt = 0; dt < DT; ++dt) dec[dt] = HG ? rdec[dt] : (f32x4){0.f, 0.f, 0.f, 0.f}; \
        LDS_BAR(); \
        if ((c_) + 2 < 64) SCAN_LOAD((c_) + 2, rqe, rks, rvt, rin, rdec); \
          \
        const f32x4 accc = mma_tile(STb + 16 * te * LQ, LQ, Qe + 16 * ti * LQ, LQ, KS, (f32x4){0.f, 0.f, 0.f, 0.f}, r, g); \
        { const float xi = HG ? 1.0f : TAB[16 * ti + r + 1]; \
          u32x2 w; w.x = pk2(bflo(inx.x) + xi * accc[0], bfhi(inx.x) + xi * accc[1]); w.y = pk2(bflo(inx.y) + xi * accc[2], bfhi(inx.y) + xi * accc[3]); \
          *(u32x2*)(outp + (size_t)(c_) * 64 * 1024) = w; } \
          \
        const float g64 = HG ? 1.0f : TAB[64]; \
        _Pragma("unroll") for (int dt = 0; dt < DT; ++dt) \
            _Pragma("unroll") for (int et = 0; et < 2; ++et) { const int d0 = dbase + 16 * dt; \
                const f32x4 dd = HG ? dec[dt] : (f32x4){g64, g64, g64, g64}; \
                st[dt][et] = mma_tile(KsT + d0 * LT, LT, VT + 16 * et * LT, LT, 2, st[dt][et] * dd, r, g); } \
        LDS_BAR(); \
    } while (0)
    SCAN_LOAD(0, rqeA, rksA, rvtA, rinA, rdecA);
    SCAN_LOAD(1, rqeB, rksB, rvtB, rinB, rdecB);
    __syncthreads();
    for (int c = 0; c < 64; c += 2) {
        SCAN_STEP(c, rqeA, rksA, rvtA, rinA, rdecA);
        SCAN_STEP(c + 1, rqeB, rksB, rvtB, rinB, rdecB);
    }
#undef SCAN_STEP
#undef SCAN_LOAD
    __syncthreads();
}

__device__ __forceinline__ void sgu_item(const Args& a, LAS unsigned char* lds, int item, int tid, int lane, int wave) {
    constexpr int LW = 136;
    constexpr int O_W = 0, O_V = O_W + 128 * LW * 2, O_ST = O_V + 256 * LW * 2;
    LAS bf16* Wm = (LAS bf16*)(lds + O_W); LAS bf16* VnT = (LAS bf16*)(lds + O_V); LAS float* ST = (LAS float*)(lds + O_ST);
    const int win = item >> 2, grp = item & 3, r = lane & 15, g = lane >> 4;
    const bf16* Z = (const bf16*)(a.ws + WS_Z); bf16* MIX0 = (bf16*)(a.ws + WS_MIX0);
    const size_t tok0 = (size_t)win * 128;
    { const float* ws_ = a.in[I_SGU_WS] + (size_t)grp * 128 * 128;
      for (int u = tid; u < 128 * 16; u += 512) { const int i = u >> 4, j0 = (u & 15) * 8;
          const f32x4 w0 = *(const f32x4*)(ws_ + i * 128 + j0), w1 = *(const f32x4*)(ws_ + i * 128 + j0 + 4);
          const bool ok = (j0 >> 6) <= (i >> 6);
          u32x4 o; o.x = ok ? pk2(w0.x, w0.y) : 0u; o.y = ok ? pk2(w0.z, w0.w) : 0u; o.z = ok ? pk2(w1.x, w1.y) : 0u; o.w = ok ? pk2(w1.z, w1.w) : 0u;
          *(LAS u32x4*)(Wm + i * LW + j0) = o; } }
#pragma unroll 1
    for (int half = 0; half < 4; ++half) {
        u32x4 p0[4], p1[4];
#pragma unroll
        for (int tt = 0; tt < 4; ++tt) { const int j = wave * 16 + half * 4 + tt; const bf16* zr = Z + (tok0 + j) * EVEN_IN + 5120;
            p0[tt] = *(const u32x4*)(zr + lane * 8); p1[tt] = *(const u32x4*)(zr + 512 + lane * 8); }
        __builtin_amdgcn_sched_barrier(0);
#pragma unroll
        for (int tt = 0; tt < 4; ++tt) { const int j = wave * 16 + half * 4 + tt;
            float x[16];
#pragma unroll
            for (int e = 0; e < 4; ++e) { x[2 * e] = bflo(p0[tt][e]); x[2 * e + 1] = bfhi(p0[tt][e]); x[8 + 2 * e] = bflo(p1[tt][e]); x[8 + 2 * e + 1] = bfhi(p1[tt][e]); }
            float s = 0.f;
#pragma unroll
            for (int e = 0; e < 16; ++e) s += x[e];
            const float mean = wave_sum(s) * (1.0f / 1024.0f); float q = 0.f;
#pragma unroll
            for (int e = 0; e < 16; ++e) { const float dd = x[e] - mean; q += dd * dd; }
            const float var = wave_sum(q) * (1.0f / 1024.0f);
            if (lane == 0) { ST[2 * j] = mean; ST[2 * j + 1] = __builtin_amdgcn_rsqf(var + EPS); } } }
    __syncthreads();
    { const float* lng = a.in[I_SGU_LNG] + 256 * grp; const float* lnb = a.in[I_SGU_LNB] + 256 * grp;
      u32x4 pv[8];
#pragma unroll
      for (int k = 0; k < 8; ++k) { const int u = tid + 512 * k; const int j = u & 127, c0 = (u >> 7) * 8; pv[k] = *(const u32x4*)(Z + (tok0 + j) * EVEN_IN + 5120 + 256 * grp + c0); }
      __builtin_amdgcn_sched_barrier(0);
#pragma unroll
      for (int k = 0; k < 8; ++k) { const int u = tid + 512 * k; const int j = u & 127, c0 = (u >> 7) * 8; const u32x4 p = pv[k];
          const float mean = ST[2 * j], rstd = ST[2 * j + 1];
#pragma unroll
          for (int e = 0; e < 4; ++e) { const float x0 = (bflo(p[e]) - mean) * rstd * lng[c0 + 2 * e] + lnb[c0 + 2 * e], x1 = (bfhi(p[e]) - mean) * rstd * lng[c0 + 2 * e + 1] + lnb[c0 + 2 * e + 1];
              VnT[(c0 + 2 * e) * LW + j] = f2bf1(x0); VnT[(c0 + 2 * e + 1) * LW + j] = f2bf1(x1); } } }
    u32x2 upv[2][8];
#pragma unroll
    for (int q = 0; q < 2; ++q)
#pragma unroll
        for (int it = 0; it < 8; ++it) upv[q][it] = *(const u32x2*)(Z + (tok0 + 16 * it + r) * EVEN_IN + 4096 + 256 * grp + 16 * (2 * wave + q) + 4 * g);
    __syncthreads();
    const float* bs = a.in[I_SGU_BS] + 128 * grp;
#pragma unroll
    for (int q = 0; q < 2; ++q)
#pragma unroll
        for (int it = 0; it < 8; ++it) { const int ct = 2 * wave + q;
            const f32x4 acc = mma_tile(VnT + 16 * ct * LW, LW, Wm + 16 * it * LW, LW, 4, (f32x4){0.f, 0.f, 0.f, 0.f}, r, g);
            const int i = 16 * it + r, c = 16 * ct + 4 * g; const float bias = bs[i];
            const u32x2 up = upv[q][it];
            u32x2 w; w.x = pk2(bflo(up.x) * (acc[0] + bias), bfhi(up.x) * (acc[1] + bias)); w.y = pk2(bflo(up.y) * (acc[2] + bias), bfhi(up.y) * (acc[3] + bias));
            *(u32x2*)(MIX0 + (tok0 + i) * DM + 1024 + 256 * grp + c) = w; }
    __syncthreads();
}

template <bool HG>
__device__ __forceinline__ void postnorm_rows(const Args& a, int gw, int NGW, int lane) {
    asm volatile("" : "+v"(lane));
    const bf16* RAW = (const bf16*)(a.ws + WS_RAW); const bf16* Z = (const bf16*)(a.ws + WS_Z);
    bf16* O = (bf16*)(a.ws + (HG ? WS_MIX1 : WS_MIX0)); const int ldo = DM, ldz = HG ? ODD_PAD : EVEN_IN;
    f32x4 ng[4];
    if (HG) {
#pragma unroll
        for (int e = 0; e < 4; ++e) ng[e] = *(const f32x4*)(a.in[I_HG_NG] + 16 * lane + 4 * e); }
    for (int m0 = gw; m0 < M; m0 += 2 * NGW) {
        u32x4 p0[2], p1[2], g0[2], g1[2];
#pragma unroll
        for (int q = 0; q < 2; ++q) { const int m = (m0 + q * NGW < M) ? m0 + q * NGW : m0;
            const bf16* rr = RAW + (size_t)m * 1024 + 16 * lane; const bf16* gr = Z + (size_t)m * ldz + 3072 + 16 * lane;
            p0[q] = *(const u32x4*)rr; p1[q] = *(const u32x4*)(rr + 8); g0[q] = *(const u32x4*)gr; g1[q] = *(const u32x4*)(gr + 8); }
#pragma unroll
        for (int q = 0; q < 2; ++q) { const int m = m0 + q * NGW; if (m >= M) break;
            float x[16], gt[16];
#pragma unroll
            for (int e = 0; e < 4; ++e) { x[2 * e] = bflo(p0[q][e]); x[2 * e + 1] = bfhi(p0[q][e]); x[8 + 2 * e] = bflo(p1[q][e]); x[8 + 2 * e + 1] = bfhi(p1[q][e]);
                gt[2 * e] = bflo(g0[q][e]); gt[2 * e + 1] = bfhi(g0[q][e]); gt[8 + 2 * e] = bflo(g1[q][e]); gt[8 + 2 * e + 1] = bfhi(g1[q][e]); }
            float s = 0.f;
#pragma unroll
            for (int e = 0; e < 16; ++e) s += x[e] * x[e];
            s = HG ? row_sum8(s) : row_sum16(s);
            const float rstd = __builtin_amdgcn_rsqf(s * (HG ? (1.0f / 128.0f) : (1.0f / 256.0f)) + EPS);
            float y[16];
#pragma unroll
            for (int e = 0; e < 16; ++e) { float v = x[e] * rstd; if (HG) v *= ng[e >> 2][e & 3]; y[e] = v * (gt[e] * __builtin_amdgcn_rcpf(1.0f + __expf(-gt[e]))); }
            u32x4 o0, o1; o0.x = pk2(y[0], y[1]); o0.y = pk2(y[2], y[3]); o0.z = pk2(y[4], y[5]); o0.w = pk2(y[6], y[7]); o1.x = pk2(y[8], y[9]); o1.y = pk2(y[10], y[11]); o1.z = pk2(y[12], y[13]); o1.w = pk2(y[14], y[15]);
            bf16* op = O + (size_t)m * ldo + 16 * lane; *(u32x4*)op = o0; *(u32x4*)(op + 8) = o1; }
    }
}
__device__ __forceinline__ void kvn_rows(const Args& a, int gw, int NGW, int lane) {
    asm volatile("" : "+v"(lane));
    const bf16* Z = (const bf16*)(a.ws + WS_Z); bf16* KVN = (bf16*)(a.ws + WS_KVN);
    for (int m = gw; m < M; m += NGW) {
        const u32x2 p = *(const u32x2*)(Z + (size_t)m * ODD_PAD + Z1_CKV + 4 * lane);
        const float x0 = bflo(p.x), x1 = bfhi(p.x), x2 = bflo(p.y), x3 = bfhi(p.y);
        const float rstd = __builtin_amdgcn_rsqf(wave_sum(x0 * x0 + x1 * x1 + x2 * x2 + x3 * x3) * (1.0f / 256.0f) + EPS);
        const f32x4 gg = *(const f32x4*)(a.in[I_CKV_G] + 4 * lane);
        u32x2 w; w.x = pk2(x0 * rstd * gg.x, x1 * rstd * gg.y); w.y = pk2(x2 * rstd * gg.z, x3 * rstd * gg.w);
        *(u32x2*)(KVN + (size_t)m * 256 + 4 * lane) = w;
        { const bf16* cr = Z + (size_t)m * ODD_PAD + Z1_CQ; float s = 0.f;
#pragma unroll
          for (int e = 0; e < 6; ++e) { const float x = bf2f(cr[lane + 64 * e]); s += x * x; }
          s = wave_sum(s) * (1.0f / 384.0f); if (lane == 0) ((float*)(a.ws + WS_MSCQ))[m] = s; }
    }
}

__device__ __forceinline__ unsigned f2key(float f) { const unsigned u = __float_as_uint(f); return u ^ ((u >> 31) ? 0xffffffffu : 0x80000000u); }


__device__ __forceinline__ int wave_sum_i(int v) {
    v += __builtin_amdgcn_update_dpp(0, v, 0xB1, 0xF, 0xF, true); v += __builtin_amdgcn_update_dpp(0, v, 0x4E, 0xF, 0xF, true);
    v += __builtin_amdgcn_update_dpp(0, v, 0x141, 0xF, 0xF, true); v += __builtin_amdgcn_update_dpp(0, v, 0x140, 0xF, 0xF, true);
    return (__builtin_amdgcn_readlane(v, 0) + __builtin_amdgcn_readlane(v, 16)) + (__builtin_amdgcn_readlane(v, 32) + __builtin_amdgcn_readlane(v, 48));
}
template <int NREG>
__device__ __forceinline__ void select_top256(const LAS float* sq, int nk, unsigned short* so, int lane) {
    unsigned key[NREG];
#pragma unroll
    for (int i = 0; i < NREG; ++i) key[i] = (64 * i < nk) ? f2key(sq[64 * i + lane]) : 0u;
    unsigned T = 0u; bool exact = false;
    for (int bit = 31; bit >= 0 && !exact; --bit) {
        const unsigned cand = T | (1u << bit); int c = 0;
#pragma unroll
        for (int i = 0; i < NREG; ++i) c += (key[i] >= cand) ? 1 : 0;
        const int cnt = wave_sum_i(c);
        if (cnt >= 256) { T = cand; if (cnt == 256) exact = true; }
    }
    int cg = 0;
#pragma unroll
    for (int i = 0; i < NREG; ++i) cg += (key[i] > T) ? 1 : 0;
    const int cgt = wave_sum_i(cg);
    int need_eq = 256 - cgt, base = 0, eq_seen = 0;
    const unsigned long long lt_mask = (lane == 0) ? 0ull : (~0ull >> (64 - lane));
#pragma unroll
    for (int i = 0; i < NREG; ++i) {
        if (64 * i < nk) {
            const bool gt = key[i] > T, eq = key[i] == T;
            const unsigned long long meq = __ballot(eq);
            const bool take = gt || (eq && (eq_seen + __popcll(meq & lt_mask) < need_eq));
            const unsigned long long ms = __ballot(take);
            if (take) { const int pos = base + __popcll(ms & lt_mask); if (pos < 256) so[pos] = (unsigned short)(64 * i + lane); }
            base += __popcll(ms); eq_seen += __popcll(meq);
        }
    }
}

__device__ __forceinline__ void idx_group(const Args& a, LAS unsigned char* lds, int grp, int tid, int lane, int wave) {
    LAS float* sc = (LAS float*)lds;
    const bf16* Z = (const bf16*)(a.ws + WS_Z); const bf16* QI = (const bf16*)(a.ws + WS_QI);
    unsigned short* SEL = (unsigned short*)(a.ws + WS_SEL); int* NSEL = (int*)(a.ws + WS_NSEL);
    const int m0 = grp * 8, b = m0 >> 12, t0 = m0 & 4095, cq = t0 >> 6, nk = 64 * (cq + 1);
    const size_t kb0 = (size_t)b * SEQ;
    if (nk <= 256) {
        for (int u = tid; u < 8 * 256; u += 512) { const int q = u >> 8, s = u & 255; SEL[(size_t)(m0 + q) * 256 + s] = (unsigned short)(s < nk ? s : 0); }
        if (tid < 8) NSEL[m0 + tid] = nk;
        return;
    }
    const int r = lane & 31, hh = lane >> 5;
    const int qsel = (r >> 2) & 1, head = (r & 3) + 4 * (r >> 3);
    bf16x8 af[4][4]; float wv[4][16];
#pragma unroll
    for (int p = 0; p < 4; ++p) { const bf16* qrow = QI + (size_t)(m0 + 2 * p + qsel) * 1024 + head * 64 + 8 * hh;
#pragma unroll
        for (int s = 0; s < 4; ++s) af[p][s] = *(const bf16x8*)(qrow + 16 * s);
        const bf16* wrow = Z + (size_t)(m0 + 2 * p + hh) * ODD_PAD + Z1_WIDX;
        const u32x4 w0 = *(const u32x4*)wrow, w1 = *(const u32x4*)(wrow + 8);
#pragma unroll
        for (int e = 0; e < 4; ++e) { wv[p][2 * e] = bflo(w0[e]); wv[p][2 * e + 1] = bfhi(w0[e]); wv[p][8 + 2 * e] = bflo(w1[e]); wv[p][8 + 2 * e + 1] = bfhi(w1[e]); } }
    const int nkt = nk >> 5;
    bf16x8 bnx[4];
    { const bf16* krow = Z + (kb0 + 32 * wave + r) * ODD_PAD + Z1_KIDX + 8 * hh;
#pragma unroll
      for (int s = 0; s < 4; ++s) bnx[s] = *(const bf16x8*)(krow + 16 * s); }
    for (int kt = wave; kt < nkt; kt += 8) {
        bf16x8 bfr[4];
#pragma unroll
        for (int s = 0; s < 4; ++s) bfr[s] = bnx[s];
        { const int ktn = (kt + 8 < nkt) ? kt + 8 : kt; const bf16* krow = Z + (kb0 + 32 * ktn + r) * ODD_PAD + Z1_KIDX + 8 * hh;
#pragma unroll
          for (int s = 0; s < 4; ++s) bnx[s] = *(const bf16x8*)(krow + 16 * s); }
        __builtin_amdgcn_sched_barrier(0);
#pragma unroll
        for (int p = 0; p < 4; ++p) {
            f32x16 acc;
#pragma unroll
            for (int e = 0; e < 16; ++e) acc[e] = 0.f;
#pragma unroll
            for (int s = 0; s < 4; ++s) acc = __builtin_amdgcn_mfma_f32_32x32x16_bf16(af[p][s], bfr[s], acc, 0, 0, 0);
            float v = 0.f;
#pragma unroll
            for (int e = 0; e < 16; ++e) v += wv[p][e] * fmaxf(acc[e], 0.f);
            sc[(2 * p + hh) * 4096 + 32 * kt + r] = v;
        }
    }
    __syncthreads();
    { unsigned short* so = SEL + (size_t)(m0 + wave) * 256; const LAS float* sq = sc + wave * 4096;
      if (nk <= 1024) select_top256<16>(sq, nk, so, lane); else if (nk <= 2048) select_top256<32>(sq, nk, so, lane); else if (nk <= 3072) select_top256<48>(sq, nk, so, lane); else select_top256<64>(sq, nk, so, lane);
      if (lane == 0) NSEL[m0 + wave] = 256; }
    __syncthreads();
}

__device__ __forceinline__ int rel_bucket(int rel) {
    const int ret = rel > 0 ? 16 : 0; const int n = rel < 0 ? -rel : rel;
    if (n < 8) return ret + n;
    int large = 8 + (int)(logf((float)n / 8.0f) / 3.4657359027997265f * 8.0f);
    large = large < 15 ? large : 15;
    return ret + large;
}
__device__ __forceinline__ unsigned kv_fx(unsigned row) { return ((row & 3u) << 2) | ((row >> 2) & 3u); }
__device__ __forceinline__ unsigned kv_off(unsigned row, unsigned ch) { return 512u * row + 16u * (ch ^ kv_fx(row)); }
typedef short s16x4 __attribute__((ext_vector_type(4)));
__device__ __forceinline__ void attn_queries(const Args& a, LAS unsigned char* lds, int q_begin, int q_end, int tid, int lane, int wave) {
    asm volatile("" : "+v"(lane)); asm volatile("" : "+v"(tid));
    constexpr int WREG = 19840, O_PW = 16384, O_ZW = 16384 + 640, O_SW = 16384 + 640 + 64, O_QW = 16384 + 640 + 64 + 512, LQW = 136, LP = 40, O_BIAS = 8 * WREG;
    static_assert(O_BIAS + 1024 <= LDS_BYTES - 128, "attention LDS map");
    LAS unsigned char* KVc = lds + wave * WREG; LAS bf16* Pw = (LAS bf16*)(KVc + O_PW); LAS float* Zw = (LAS float*)(KVc + O_ZW); LAS unsigned short* SELw = (LAS unsigned short*)(KVc + O_SW); LAS bf16* Qw = (LAS bf16*)(KVc + O_QW); LAS float* BIAS = (LAS float*)(lds + O_BIAS);
    const bf16* QRAW = (const bf16*)(a.ws + WS_QRAW); const bf16* KVN = (const bf16*)(a.ws + WS_KVN);
    const unsigned short* SEL = (const unsigned short*)(a.ws + WS_SEL); const int* NSEL = (const int*)(a.ws + WS_NSEL); const float* MSCQ = (const float*)(a.ws + WS_MSCQ);
    bf16* OBUF = (bf16*)(a.ws + WS_OBUF);
    const int r = lane & 15, g = lane >> 4, part = lane & 31, sub = lane >> 5, hq = r & 7;
    const unsigned q4 = (unsigned)(lane & 15) >> 2, p4 = (unsigned)lane & 3u;
    if (tid < 256) BIAS[tid] = a.in[I_RELB][tid];
    __syncthreads();
    for (int m = q_begin + wave; m < q_end; m += 8) {
        const int t = m & 4095; const size_t kb0 = (size_t)(m >> 12) * SEQ;
        const int nch = __builtin_amdgcn_readfirstlane(NSEL[m]) >> 5;
        const unsigned short* selm = SEL + (size_t)m * 256;
        { const u32x2 sv = *(const u32x2*)((const char*)SEL + ((unsigned)m * 512u + 8u * (unsigned)lane)); *(LAS u32x2*)(SELw + 4 * lane) = sv; }
        asm volatile("" ::: "memory");
        bf16x8 qf[8];
        { u32x4 raw[8]; float ss = 0.f;
#pragma unroll
          for (int s = 0; s < 8; ++s) { raw[s] = *(const u32x4*)((const char*)QRAW + ((unsigned)m * 4096u + (unsigned)(512 * hq + 64 * s + 16 * g)));
#pragma unroll
              for (int e = 0; e < 4; ++e) { const float x0 = bflo(raw[s][e]), x1 = bfhi(raw[s][e]); ss += x0 * x0 + x1 * x1; } }
          ss += __shfl_xor(ss, 16); ss += __shfl_xor(ss, 32);
          const float rstd = __builtin_amdgcn_rsqf(ss * (1.0f / 256.0f) + EPS * (MSCQ[m] + EPS));
#pragma unroll
          for (int s = 0; s < 8; ++s) { const f32x4 g0 = *(const f32x4*)(a.in[I_QN_G] + 32 * s + 8 * g), g1 = *(const f32x4*)(a.in[I_QN_G] + 32 * s + 8 * g + 4);
              u32x4 w; w.x = pk2(bflo(raw[s].x) * rstd * g0.x, bfhi(raw[s].x) * rstd * g0.y); w.y = pk2(bflo(raw[s].y) * rstd * g0.z, bfhi(raw[s].y) * rstd * g0.w);
              w.z = pk2(bflo(raw[s].z) * rstd * g1.x, bfhi(raw[s].z) * rstd * g1.y); w.w = pk2(bflo(raw[s].w) * rstd * g1.z, bfhi(raw[s].w) * rstd * g1.w);
              qf[s] = __builtin_bit_cast(bf16x8, w); } }
        if (r < 8) {
#pragma unroll
            for (int s = 4; s < 8; ++s) *(LAS bf16x8*)(Qw + hq * LQW + 32 * (s - 4) + 8 * g) = qf[s]; }
        asm volatile("" ::: "memory");
        u32x4 pre[16];
        { u32x4 iw[4];
#pragma unroll
          for (int k = 0; k < 4; ++k) iw[k] = *(const LAS u32x4*)(SELw + 8 * k);
#pragma unroll
          for (int i = 0; i < 16; ++i) { const unsigned idx = (iw[i >> 2][i & 3] >> (16 * sub)) & 0xffffu; pre[i] = *(const u32x4*)((const char*)KVN + (((unsigned)kb0 + idx) * 512u + 16u * (unsigned)part)); } }
        f32x4 o[16]; f32x4 zs = (f32x4){0.f, 0.f, 0.f, 0.f};
#pragma unroll
        for (int c2 = 0; c2 < 16; ++c2) o[c2] = (f32x4){0.f, 0.f, 0.f, 0.f};
        const unsigned fxr = kv_fx((unsigned)r);
        for (int c = 0; c < nch; ++c) {
#pragma unroll
            for (int i = 0; i < 16; ++i) *(LAS u32x4*)(KVc + kv_off((unsigned)(2 * i + sub), (unsigned)part)) = pre[i];
            const int kp0 = (int)SELw[32 * c + r], kp1 = (int)SELw[32 * c + 16 + r];
            asm volatile("" ::: "memory");
            if (c + 1 < nch) { u32x4 iw[4];
#pragma unroll
                for (int k = 0; k < 4; ++k) iw[k] = *(const LAS u32x4*)(SELw + 32 * (c + 1) + 8 * k);
#pragma unroll
                for (int i = 0; i < 16; ++i) { const unsigned idx = (iw[i >> 2][i & 3] >> (16 * sub)) & 0xffffu; pre[i] = *(const u32x4*)((const char*)KVN + (((unsigned)kb0 + idx) * 512u + 16u * (unsigned)part)); } }
            f32x4 acc0 = (f32x4){0.f, 0.f, 0.f, 0.f}, acc1 = (f32x4){0.f, 0.f, 0.f, 0.f};
            { const LAS unsigned char* rowp0 = KVc + 512 * r; const LAS unsigned char* rowp1 = rowp0 + 512 * 16;
#pragma unroll
              for (int s = 0; s < 8; ++s) { const unsigned so = 16u * ((unsigned)(4 * s + g) ^ fxr);
                  const bf16x8 k0 = *(const LAS bf16x8*)(rowp0 + so), k1 = *(const LAS bf16x8*)(rowp1 + so);
                  const bf16x8 qs = (s < 4) ? qf[s] : *(const LAS bf16x8*)(Qw + hq * LQW + 32 * (s - 4) + 8 * g);
                  acc0 = __builtin_amdgcn_mfma_f32_16x16x32_bf16(qs, k0, acc0, 0, 0, 0); acc1 = __builtin_amdgcn_mfma_f32_16x16x32_bf16(qs, k1, acc1, 0, 0, 0); } }
            { const int gg = g & 1; const int b0 = rel_bucket(kp0 - t), b1 = rel_bucket(kp1 - t);
              const f32x4 bb0 = *(const LAS f32x4*)(BIAS + b0 * 8 + 4 * gg), bb1 = *(const LAS f32x4*)(BIAS + b1 * 8 + 4 * gg);
              f32x4 p0, p1;
#pragma unroll
              for (int jj = 0; jj < 4; ++jj) { p0[jj] = __expf(acc0[jj] * 0.0625f + bb0[jj] - 8.0f); p1[jj] = __expf(acc1[jj] * 0.0625f + bb1[jj] - 8.0f); }
              zs += p0 + p1;
              if (g < 2) {
#pragma unroll
                  for (int jj = 0; jj < 4; ++jj) { Pw[(4 * g + jj) * LP + r] = f2bf1(p0[jj]); Pw[(4 * g + jj) * LP + 16 + r] = f2bf1(p1[jj]); } } }
            asm volatile("" ::: "memory");
            { const bf16x8 pf = *(const LAS bf16x8*)(Pw + hq * LP + 8 * g);
              LAS unsigned char* kvp = KVc; asm volatile("" : "+v"(kvp));
              const unsigned row0 = 8u * g + q4, row1 = row0 + 4u;
#pragma unroll
              for (int c2 = 0; c2 < 16; ++c2) { const unsigned ch = 2u * c2 + (p4 >> 1);
                  const s16x4 a0 = __builtin_amdgcn_ds_read_tr16_b64_v4i16((LAS s16x4*)(kvp + kv_off(row0, ch) + 8u * (p4 & 1u)));
                  const s16x4 a1 = __builtin_amdgcn_ds_read_tr16_b64_v4i16((LAS s16x4*)(kvp + kv_off(row1, ch) + 8u * (p4 & 1u)));
                  const bf16x8 af = {a0[0], a0[1], a0[2], a0[3], a1[0], a1[1], a1[2], a1[3]};
                  o[c2] = __builtin_amdgcn_mfma_f32_16x16x32_bf16(af, pf, o[c2], 0, 0, 0); } }
            asm volatile("" ::: "memory");
        }
        { const float z0 = row_sum16(zs[0]), z1 = row_sum16(zs[1]), z2 = row_sum16(zs[2]), z3 = row_sum16(zs[3]);
          if (g < 2 && r == 0) { Zw[4 * g] = z0; Zw[4 * g + 1] = z1; Zw[4 * g + 2] = z2; Zw[4 * g + 3] = z3; }
          asm volatile("" ::: "memory");
          const float iz = 1.0f / Zw[hq];
          if (r < 8) { const unsigned oo = (unsigned)m * 4096u + (unsigned)(512 * r + 8 * g);
#pragma unroll
              for (int c2 = 0; c2 < 16; ++c2) { u32x2 w; w.x = pk2(o[c2][0] * iz, o[c2][1] * iz); w.y = pk2(o[c2][2] * iz, o[c2][3] * iz); *(u32x2*)((char*)OBUF + (oo + 32u * c2)) = w; } }
          asm volatile("" ::: "memory"); }
    }
    __syncthreads();
}

__device__ __forceinline__ void uv_project(const Args& a, int u_begin, int u_end, int u_step, int lane) {
    asm volatile("" : "+v"(lane));
    const bf16* OBUF = (const bf16*)(a.ws + WS_OBUF); const bf16* WUVT = (const bf16*)(a.ws + WS_WUVT); bf16* MIX1 = (bf16*)(a.ws + WS_MIX1);
    const int r = lane & 15, g = lane >> 4;
    for (int u = u_begin; u < u_end; u += u_step) { const int h = u & 7, mt = u >> 3;
        bf16x8 of[8];
#pragma unroll
        for (int s = 0; s < 8; ++s) of[s] = *(const bf16x8*)(OBUF + (size_t)(16 * mt + r) * 2048 + 256 * h + 32 * s + 8 * g);
#pragma unroll
        for (int np = 0; np < 4; ++np) { bf16x8 wf[2][8];
#pragma unroll
            for (int q = 0; q < 2; ++q) { const bf16* wr = WUVT + ((size_t)h * 128 + 16 * (2 * np + q) + r) * 256 + 8 * g;
#pragma unroll
                for (int s = 0; s < 8; ++s) wf[q][s] = *(const bf16x8*)(wr + 32 * s); }
            __builtin_amdgcn_sched_barrier(0);
#pragma unroll
            for (int q = 0; q < 2; ++q) { f32x4 acc = (f32x4){0.f, 0.f, 0.f, 0.f};
#pragma unroll
                for (int s = 0; s < 8; ++s) acc = __builtin_amdgcn_mfma_f32_16x16x32_bf16(wf[q][s], of[s], acc, 0, 0, 0);
                u32x2 w; w.x = pk2(acc[0], acc[1]); w.y = pk2(acc[2], acc[3]);
                *(u32x2*)(MIX1 + (size_t)(16 * mt + r) * DM + 1024 + 128 * h + 16 * (2 * np + q) + 4 * g) = w; }
            __builtin_amdgcn_sched_barrier(0); }
    }
}

#ifndef MK_SINGLE
#define MK_SINGLE 1
#endif
#ifndef PG8_SP2
#define PG8_SP2 true
#endif
#ifndef PG8_ALIGN
#define PG8_ALIGN true
#endif

__global__ void __launch_bounds__(512, 2) mk_fwd(Args a) {
    __builtin_assume(__builtin_amdgcn_workitem_id_y() == 0); __builtin_assume(__builtin_amdgcn_workitem_id_z() == 0);
    extern __shared__ __attribute__((aligned(16))) unsigned char lds_raw[];
    LAS unsigned char* lds = (LAS unsigned char*)lds_raw;
    cg::grid_group grid = cg::this_grid();
    const int tid = threadIdx.x, lane = tid & 63, wave = __builtin_amdgcn_readfirstlane(tid >> 6);
    const int G = gridDim.x, bx = blockIdx.x;
    const int gw = bx * 8 + wave, NGW = G * 8;
    unsigned char* ws = a.ws;
    const int lo = a.ph_lo, hi = a.ph_hi;
#define IN(k) (lo <= (k) && (k) < hi)
    volatile LAS unsigned* xst = (volatile LAS unsigned*)(lds + LDS_BYTES - 64);
    if (tid < 16) xst[tid] = 0u;
    __syncthreads();
    const bool fused = (hi - lo) > 1;
    XcdBarrier xbar; xbar.bar = (unsigned*)(a.ws + WS_BAR); xbar.x = 0; xbar.st = xst;
    if (fused) xbar = xcd_barrier_post((unsigned*)(a.ws + WS_BAR), xst);
#define SEAM(k) do { if (IN(k) && IN((k) + 1)) xcd_barrier(xbar); } while (0)
    if (lo < 0) grid.sync();
#ifndef PROBE_REP_MASK
#define PROBE_REP_MASK 0
#endif
#define REP(k) for (int rep_ = 0; rep_ <= ((PROBE_REP_MASK >> (k)) & 1); ++rep_)
#define RSYNC() do { if (rep_) grid.sync(); } while (0)
    bf16* XN = (bf16*)(ws + WS_XN); bf16* Zb = (bf16*)(ws + WS_Z); float* X1 = (float*)(ws + WS_X1); float* SSQ = (float*)(ws + WS_SSQ);

    if (IN(0)) { p0_prologue(a, lds, tid, lane, wave, G); }
    SEAM(0);
    if (IN(1)) { pg8::Gemm g{XN, (const bf16*)(ws + WS_WIN0), M, EVEN_IN, DM, DM, DM}; pg8::StaticOrder S; S.init(M, EVEN_IN, G, bx);
        pg8::EpiBf16 E{Zb, EVEN_IN, Zb, EVEN_IN, 1 << 30, 16, nullptr};
        pg8::gemm_phase<pg8::EpiBf16, PG8_ALIGN, PG8_SP2>(lds, g, S, E); }
    SEAM(1);
    if (IN(2)) {
        for (int it = bx; it < 512; it += G) prep_item<256, false>(a, lds, it, tid, lane, wave);
    }
    SEAM(2);
    if (IN(3)) {
        if (bx < 64) { if (!(a.flags & 1)) scan_item<256, false>(a, lds, bx, tid, lane, wave); }
        else { if (!(a.flags & 2)) { conv_set<1>(a, lds, tid, lane, wave, (bx - 64) * 8 + wave, (G - 64) * 8, (bx - 64) * 512 + tid, (G - 64) * 512);
                conv_set<3>(a, lds, tid, lane, wave, (bx - 64) * 8 + wave, (G - 64) * 8, (bx - 64) * 512 + tid, (G - 64) * 512); }
            __syncthreads();
            for (int it = bx - 64; it < 256; it += G - 64) sgu_item(a, lds, it, tid, lane, wave); }
    }
    SEAM(3);
    if (IN(4)) postnorm_rows<false>(a, gw, NGW, lane);
    SEAM(4);
    if (IN(5)) { pg8::Gemm g{(const bf16*)(ws + WS_MIX0), (const bf16*)(ws + WS_WOUT0), M, DM, DM, DM, DM}; pg8::StaticOrder S; S.init(M, DM, G, bx);
        pg8::EpiRes E{a.in[I_X], X1, DM, XN, SSQ};
        pg8::gemm_phase<pg8::EpiRes, PG8_ALIGN, PG8_SP2>(lds, g, S, E); }
    SEAM(5);
    if (IN(6)) { pg8::Gemm g{XN, (const bf16*)(ws + WS_WGU0), M, 2 * FF, DM, DM, DM}; pg8::StaticOrder S; S.init(M, 2 * FF, G, bx);
        pg8::EpiSwiglu E{Zb, FF, SSQ};
        pg8::gemm_phase<pg8::EpiSwiglu, PG8_ALIGN, PG8_SP2>(lds, g, S, E); }
    SEAM(6);
    if (IN(7)) { pg8::Gemm g{Zb, (const bf16*)(ws + WS_WD0), M, DM, FF, FF, FF}; pg8::StaticOrder S; S.init(M, DM, G, bx);
        pg8::EpiRes E{X1, a.out, DM, XN, SSQ + M};
        pg8::gemm_phase<pg8::EpiRes, PG8_ALIGN, PG8_SP2>(lds, g, S, E); }
    SEAM(7);
    if (IN(8)) { pg8::Gemm g{XN, (const bf16*)(ws + WS_WIN1), M, ODD_PAD, DM, DM, DM}; pg8::StaticOrder S; S.init(M, ODD_PAD, G, bx);
        pg8::EpiBf16 E{Zb, ODD_PAD, Zb, ODD_PAD, 1 << 30, 1 << 30, SSQ + M};
        pg8::gemm_phase<pg8::EpiBf16, PG8_ALIGN, PG8_SP2>(lds, g, S, E); }
    SEAM(8);
    if (IN(9)) {
        for (int it = bx; it < 1024; it += G) prep_item<128, true>(a, lds, it, tid, lane, wave);
        kvn_rows(a, gw, NGW, lane);
        asm volatile("s_waitcnt vmcnt(0)" ::: "memory"); __syncthreads();
        pg8::Gemm g{Zb + Z1_CQ, (const bf16*)(ws + WS_WDSA), M, 3072, 384, ODD_PAD, 384}; pg8::StaticOrder S; S.init(M, 3072, G, bx);
        pg8::EpiBf16 E{(bf16*)(ws + WS_QRAW), 2048, (bf16*)(ws + WS_QI), 1024, 8, 1 << 30, nullptr};
        pg8::gemm_phase<pg8::EpiBf16, PG8_ALIGN, PG8_SP2>(lds, g, S, E);
    }
    SEAM(9);
    if (IN(10)) {
        if (bx < 64) { if (!(a.flags & 1)) scan_item<128, true>(a, lds, bx, tid, lane, wave); }
        else { if (!(a.flags & 2)) conv_set<2>(a, lds, tid, lane, wave, (bx - 64) * 8 + wave, (G - 64) * 8, (bx - 64) * 512 + tid, (G - 64) * 512); }
        { unsigned* qc = (unsigned*)(ws + WS_QCNT) + ((a.flags & 64) ? 16 : 0); LAS int* sh = (LAS int*)(lds + LDS_BYTES - 96);
          __syncthreads();
          for (;;) {
              if (tid == 0) sh[0] = (int)__hip_atomic_fetch_add(qc, 1u, __ATOMIC_RELAXED, __HIP_MEMORY_SCOPE_AGENT);
              __syncthreads();
              const int j = sh[0];
              __syncthreads();
              if (j >= 1024) break;
              const int c = 63 - (j >> 4), w16 = j & 15; const int grp = (w16 >> 3) * 512 + c * 8 + (w16 & 7);
              idx_group(a, lds, grp, tid, lane, wave); } }
    }
    SEAM(10);
    if (IN(12)) {
        postnorm_rows<true>(a, gw, NGW, lane);
        { int qb, qe;
          if (G == 256) { const int x = bx & 7, j = bx >> 3; qb = (x & 1) * SEQ + 32 * ((x >> 1) * 32 + j); qe = qb + 32; }
          else { const int per = (M + G - 1) / G; qb = bx * per; qe = (qb + per < M) ? qb + per : M; }
          attn_queries(a, lds, qb, qe, tid, lane, wave);
          if (G == 256) { asm volatile("s_waitcnt vmcnt(0)" ::: "memory"); __syncthreads(); uv_project(a, (qb >> 4) * 8 + wave, (qb >> 4) * 8 + 16, 8, lane); } }
    }
    SEAM(12);
    if (IN(13)) { if (G != 256) uv_project(a, gw, (M / 16) * 8, NGW, lane); }
    if (G != 256) SEAM(13);
    if (IN(14)) { pg8::Gemm g{(const bf16*)(ws + WS_MIX1), (const bf16*)(ws + WS_WOUT1), M, DM, DM, DM, DM}; pg8::StaticOrder S; S.init(M, DM, G, bx);
        pg8::EpiRes E{a.out, X1, DM, XN, SSQ + 2 * M};
        pg8::gemm_phase<pg8::EpiRes, PG8_ALIGN, PG8_SP2>(lds, g, S, E); }
    SEAM(14);
    if (IN(15)) { pg8::Gemm g{XN, (const bf16*)(ws + WS_WGU1), M, 2 * FF, DM, DM, DM}; pg8::StaticOrder S; S.init(M, 2 * FF, G, bx);
        pg8::EpiSwiglu E{Zb, FF, SSQ + 2 * M};
        pg8::gemm_phase<pg8::EpiSwiglu, PG8_ALIGN, PG8_SP2>(lds, g, S, E); }
    SEAM(15);
    if (IN(16)) { pg8::Gemm g{Zb, (const bf16*)(ws + WS_WD1), M, DM, FF, FF, FF}; pg8::StaticOrder S; S.init(M, DM, G, bx);
        pg8::EpiRes E{X1, a.out, DM, nullptr, nullptr};
        pg8::gemm_phase<pg8::EpiRes, PG8_ALIGN, PG8_SP2>(lds, g, S, E); }
#undef IN
#undef SEAM
}

extern "C" void kernel_launch(void* const* d_in, const int* in_sizes, int n_in, void* d_out, int out_size, void* d_ws, size_t ws_size, hipStream_t stream) {
    static int grid = 0;
    if (grid == 0) {
        if (n_in != 23 || out_size != M * DM || ws_size < WS_END) { fprintf(stderr, "kernel_launch: unexpected shapes (n_in %d out %d ws %zu, need %zu)\n", n_in, out_size, ws_size, (size_t)WS_END); grid = -1; return; }
        int dev = 0, cus = 0, per_cu = 0;
        if (hipGetDevice(&dev) != hipSuccess || hipDeviceGetAttribute(&cus, hipDeviceAttributeMultiprocessorCount, dev) != hipSuccess) { grid = -1; return; }
        if (hipFuncSetAttribute((const void*)mk_fwd, hipFuncAttributeMaxDynamicSharedMemorySize, LDS_BYTES) != hipSuccess) { fprintf(stderr, "kernel_launch: hipFuncSetAttribute failed\n"); grid = -1; return; }
        if (hipOccupancyMaxActiveBlocksPerMultiprocessor(&per_cu, (const void*)mk_fwd, 512, LDS_BYTES) != hipSuccess || per_cu < 1) { fprintf(stderr, "kernel_launch: occupancy query says %d blocks per CU\n", per_cu); (void)hipGetLastError(); grid = -1; return; }
        grid = cus;
        if (grid != 256) fprintf(stderr, "kernel_launch: note: %d CUs (work split assumes 256)\n", grid);
    }
    if (grid < 0) return;
    Args a{};
    for (int i = 0; i < 23; ++i) a.in[i] = (const float*)d_in[i];
    a.out = (float*)d_out; a.ws = (unsigned char*)d_ws;
    if (hipMemsetAsync((unsigned char*)d_ws + WS_BAR, 0, BAR_BYTES, stream) != hipSuccess) { fprintf(stderr, "kernel_launch: hipMemsetAsync failed\n"); return; }
#if MK_SINGLE
    a.ph_lo = 0; a.ph_hi = NPHASES;
    void* args[] = {&a};
    hipError_t e = hipLaunchCooperativeKernel((const void*)mk_fwd, dim3(grid), dim3(512), args, LDS_BYTES, stream);
    if (e != hipSuccess) fprintf(stderr, "kernel_launch: cooperative launch failed: %s\n", hipGetErrorString(e));
#else
#ifndef PROBE_HOST_MASK
#define PROBE_HOST_MASK 0
#endif
#ifndef PROBE_REP_FLAGS
#define PROBE_REP_FLAGS 0
#endif
#ifndef PROBE_REP_COUNT
#define PROBE_REP_COUNT 1
#endif
    for (int p = 0; p < NPHASES; ++p) for (int rep = 0; rep <= (((PROBE_HOST_MASK >> p) & 1) ? PROBE_REP_COUNT : 0); ++rep) { a.ph_lo = p; a.ph_hi = p + 1; a.flags = rep ? PROBE_REP_FLAGS : 0; void* args[] = {&a};
        hipError_t e = hipLaunchCooperativeKernel((const void*)mk_fwd, dim3(grid), dim3(512), args, LDS_BYTES, stream);
        if (e != hipSuccess) { fprintf(stderr, "kernel_launch: launch %d failed: %s\n", p, hipGetErrorString(e)); break; } }
#endif
}
```

```cpp
#include <hip/hip_runtime.h>
#include <hip/hip_cooperative_groups.h>
#include <cstdio>
#include <cstdint>
namespace cg = cooperative_groups;

#define LAS __attribute__((address_space(3)))
typedef unsigned short bf16;
typedef short bf16x8 __attribute__((ext_vector_type(8)));
typedef float f32x2 __attribute__((ext_vector_type(2)));
typedef float f32x4 __attribute__((ext_vector_type(4)));
typedef float f32x16 __attribute__((ext_vector_type(16)));
typedef unsigned u32x2 __attribute__((ext_vector_type(2)));
typedef unsigned u32x4 __attribute__((ext_vector_type(4)));

constexpr int BATCH = 2, SEQ = 4096, DM = 2048, M = BATCH * SEQ, FF = 5632;
constexpr int EVEN_IN = 6144, ODD_IN = 4816, ODD_PAD = 4864;
constexpr float EPS = 1e-6f;
constexpr int Z1_HQ = 0, Z1_HF = 1024, Z1_HI = 2048, Z1_HGATE = 3072, Z1_CQ = 4096, Z1_CKV = 4480, Z1_KIDX = 4736, Z1_WIDX = 4800;

__device__ __forceinline__ unsigned f2bf(float f) { unsigned u = __float_as_uint(f); return (u + 0x7fffu + ((u >> 16) & 1u)) >> 16; }
typedef __bf16 bf16x2_t __attribute__((ext_vector_type(2)));
__device__ __forceinline__ unsigned pk2(float lo, float hi) { const f32x2 v = {lo, hi}; const bf16x2_t b = __builtin_convertvector(v, bf16x2_t); return __builtin_bit_cast(unsigned, b); }
__device__ __forceinline__ bf16 f2bf1(float f) { return (bf16)(pk2(f, 0.f) & 0xffffu); }
__device__ __forceinline__ float bflo(unsigned w) { return __uint_as_float(w << 16); }
__device__ __forceinline__ float bfhi(unsigned w) { return __uint_as_float(w & 0xffff0000u); }
__device__ __forceinline__ float bf2f(bf16 b) { return __uint_as_float(((unsigned)b) << 16); }
template <int CTRL> __device__ __forceinline__ float dpp_f(float x) { return __builtin_bit_cast(float, __builtin_amdgcn_update_dpp(0, __builtin_bit_cast(int, x), CTRL, 0xF, 0xF, true)); }
__device__ __forceinline__ float row_sum8(float x) { x += dpp_f<0xB1>(x); x += dpp_f<0x4E>(x); x += dpp_f<0x141>(x); return x; }
__device__ __forceinline__ float row_sum16(float x) { x = row_sum8(x); x += dpp_f<0x140>(x); return x; }
__device__ __forceinline__ float row_max16(float x) { x = fmaxf(x, dpp_f<0xB1>(x)); x = fmaxf(x, dpp_f<0x4E>(x)); x = fmaxf(x, dpp_f<0x141>(x)); x = fmaxf(x, dpp_f<0x140>(x)); return x; }
__device__ __forceinline__ float rdlane(float x, int l) { return __builtin_bit_cast(float, __builtin_amdgcn_readlane(__builtin_bit_cast(int, x), l)); }
__device__ __forceinline__ float wave_sum(float v) { v = row_sum16(v); return (rdlane(v, 0) + rdlane(v, 16)) + (rdlane(v, 32) + rdlane(v, 48)); }
__device__ __forceinline__ float wave_max(float v) { v = row_max16(v); return fmaxf(fmaxf(rdlane(v, 0), rdlane(v, 16)), fmaxf(rdlane(v, 32), rdlane(v, 48))); }
__device__ __forceinline__ float sigmoidf_(float x) { return 1.0f / (1.0f + __expf(-x)); }
__device__ __forceinline__ float siluf_(float x) { return x / (1.0f + __expf(-x)); }
#define LDS_WAIT() asm volatile("s_waitcnt lgkmcnt(0)" ::: "memory")
#define LDS_BAR() do { asm volatile("s_waitcnt lgkmcnt(0)" ::: "memory"); __builtin_amdgcn_s_barrier(); asm volatile("" ::: "memory"); } while (0)

#ifndef PG8_WGM
#define PG8_WGM 2
#endif
namespace pg8 {
constexpr int BM = 256, BK = 64, HALF = 128, HTB = HALF * BK * 2  , STAGE_BYTES = 8 * HTB, NXCD = 8, WGM = PG8_WGM;

__host__ __device__ __forceinline__ int lds_byte(int r, int c) { const int st = (r >> 4) * 2 + (c >> 5), rr = r & 15, cc = c & 31, ob = rr * 64 + cc * 2; return st * 1024 + (ob ^ (((ob >> 9) & 1) << 5)); }
__host__ __device__ __forceinline__ void stage_rc(int b, int& R, int& C) { const int st = b / 1024, sb = b % 1024, swz = sb ^ (((sb >> 9) & 1) << 5); R = (st >> 1) * 16 + swz / 64; C = (st & 1) * 32 + (swz % 64) / 2; }
__host__ __device__ __forceinline__ int perm32(int rho) { const int n = rho >> 4, i = rho & 15; return 8 * (i >> 2) + 4 * n + (i & 3); }

struct Unit { int pm, pn, half; };
struct Gemm { const bf16* A; const bf16* Bt; int M, N, K, lda, ldb; };

struct StaticOrder {
    int nM, nN, nwg, G, c, wgm;
    __host__ __device__ void init(int M_, int N_, int G_, int c_, int wgm_ = WGM) { nM = M_ / BM; nN = N_ / BM; nwg = nM * nN; G = G_; c = c_; wgm = wgm_; }
    __host__ __device__ bool next(int i, Unit& u) const {
        if (c < 0) return false;
        const int base = i * G, rem = nwg - base; if (rem <= 0) return false;
        long L; u.half = -1;
        if (rem >= G || 2 * rem > G) { L = (long)base + c; if (L >= nwg) return false; }
        else { if (c >= 2 * rem) return false; L = (long)base + (c >> 1); u.half = c & 1; }
        int wgid = (int)L;
#ifndef PG8_NO_XCD_REMAP
        { const int q = nwg / NXCD, r = nwg % NXCD, xcd = wgid % NXCD, off = wgid / NXCD; wgid = (xcd < r ? xcd * (q + 1) : r * (q + 1) + (xcd - r) * q) + off; }
#endif
        const int nig = wgm * nN, gid = wgid / nig, fm = gid * wgm, gsz = (nM - fm) < wgm ? (nM - fm) : wgm;
        u.pm = fm + ((wgid % nig) % gsz); u.pn = (wgid % nig) / gsz; return true;
    }
};

__device__ __forceinline__ unsigned cvt_pk_bf16(float lo, float hi) { return pk2(lo, hi); }
__device__ __forceinline__ f32x2 gelu_pk(f32x2 v) {
    const f32x2 av = __builtin_elementwise_abs(v), d = av * 0.2316418882f + 1.0f;
    f32x2 t; t.x = __builtin_amdgcn_rcpf(d.x); t.y = __builtin_amdgcn_rcpf(d.y);
    f32x2 q = t * 0.5307027145f + (-0.7265760135f); q = q * t + 0.7107068705f; q = q * t + (-0.142248368f); q = q * t + 0.127414796f; q = q * t;
    const f32x2 s = (v * v) * (-0.72134752044f);
    f32x2 e; e.x = __builtin_amdgcn_exp2f(s.x); e.y = __builtin_amdgcn_exp2f(s.y);
    const f32x2 m = v * (q * e), r = v - m;
    f32x2 o; o.x = v.x < 0.f ? m.x : r.x; o.y = v.y < 0.f ? m.y : r.y; return o;
}

struct EpiBf16 {
    static constexpr bool PERM = true;
    bf16* O0; int ld0; bf16* O1; int ld1; int split_pn; int gelu_pn; const float* ssq;
    __device__ __forceinline__ void operator()(const f32x4 (&acc)[2][2][4][2], const Unit& u, int wr, int wc, int fr, int fq) const {
        const int row0 = u.pm * BM + wr * 64 + fr;
        bf16* base = O0; int ldc = ld0; int colt = u.pn * BM;
        if (u.pn >= split_pn) { base = O1; ldc = ld1; colt = (u.pn - split_pn) * BM; }
        const bool act = u.pn >= gelu_pn;
        const int col0 = colt + wc * 32 + 8 * fq;
#pragma unroll
        for (int ai = 0; ai < 2; ++ai) { if (u.half >= 0 && u.half != ai) continue;
#pragma unroll
            for (int m = 0; m < 4; ++m) { const int row = row0 + ai * HALF + m * 16; bf16* rowp = base + (size_t)row * ldc + col0;
                const float rs = ssq ? __builtin_amdgcn_rsqf(ssq[row] * (1.0f / 2048.0f) + 1e-6f) : 1.0f;
#pragma unroll
                for (int bj = 0; bj < 2; ++bj) { f32x4 v0 = acc[ai][bj][m][0] * rs, v1 = acc[ai][bj][m][1] * rs;
                    if (act) { f32x2 a = gelu_pk((f32x2){v0[0], v0[1]}), b = gelu_pk((f32x2){v0[2], v0[3]}), c = gelu_pk((f32x2){v1[0], v1[1]}), d = gelu_pk((f32x2){v1[2], v1[3]});
                        v0 = (f32x4){a.x, a.y, b.x, b.y}; v1 = (f32x4){c.x, c.y, d.x, d.y}; }
                    u32x4 w; w.x = cvt_pk_bf16(v0[0], v0[1]); w.y = cvt_pk_bf16(v0[2], v0[3]); w.z = cvt_pk_bf16(v1[0], v1[1]); w.w = cvt_pk_bf16(v1[2], v1[3]);
                    *(u32x4*)(rowp + bj * HALF) = w; } } }
    }
};
struct EpiRes {
    static constexpr bool PERM = true;
    const float* base; float* out; int ldc; bf16* xb; float* ssq;
    __device__ __forceinline__ void operator()(const f32x4 (&acc)[2][2][4][2], const Unit& u, int wr, int wc, int fr, int fq) const {
        const int row0 = u.pm * BM + wr * 64 + fr, col0 = u.pn * BM + wc * 32 + 8 * fq;
#pragma unroll
        for (int ai = 0; ai < 2; ++ai) { if (u.half >= 0 && u.half != ai) continue;
#pragma unroll
            for (int m = 0; m < 4; ++m) { const int row = row0 + ai * HALF + m * 16; const size_t off = (size_t)row * ldc + col0; float sq = 0.f;
#pragma unroll
                for (int bj = 0; bj < 2; ++bj) { const f32x4 b0 = *(const f32x4*)(base + off + bj * HALF), b1 = *(const f32x4*)(base + off + bj * HALF + 4);
                    const f32x4 v0 = b0 + acc[ai][bj][m][0], v1 = b1 + acc[ai][bj][m][1];
                    *(f32x4*)(out + off + bj * HALF) = v0; *(f32x4*)(out + off + bj * HALF + 4) = v1;
                    if (xb) { u32x4 w; w.x = cvt_pk_bf16(v0[0], v0[1]); w.y = cvt_pk_bf16(v0[2], v0[3]); w.z = cvt_pk_bf16(v1[0], v1[1]); w.w = cvt_pk_bf16(v1[2], v1[3]); *(u32x4*)(xb + off + bj * HALF) = w;
                        sq += ((v0[0] * v0[0] + v0[1] * v0[1]) + (v0[2] * v0[2] + v0[3] * v0[3])) + ((v1[0] * v1[0] + v1[1] * v1[1]) + (v1[2] * v1[2] + v1[3] * v1[3])); } }
                if (xb) { sq += __shfl_xor(sq, 16); sq += __shfl_xor(sq, 32); if (fq == 0) atomicAdd(ssq + row, sq); }
                asm volatile("" ::: "memory"); } }
    }
};
struct EpiSwiglu {
    static constexpr bool PERM = true;
    bf16* O; int ldc; const float* ssq;
    __device__ __forceinline__ void operator()(const f32x4 (&acc)[2][2][4][2], const Unit& u, int wr, int wc, int fr, int fq) const {
        const int row0 = u.pm * BM + wr * 64 + fr, col0 = u.pn * HALF + wc * 32 + 8 * fq;
#pragma unroll
        for (int ai = 0; ai < 2; ++ai) { if (u.half >= 0 && u.half != ai) continue;
#pragma unroll
            for (int m = 0; m < 4; ++m) { const int row = row0 + ai * HALF + m * 16; bf16* rowp = O + (size_t)row * ldc + col0;
                const float rs = __builtin_amdgcn_rsqf(ssq[row] * (1.0f / 2048.0f) + 1e-6f);
                float r[8];
#pragma unroll
                for (int n = 0; n < 2; ++n)
#pragma unroll
                    for (int j = 0; j < 4; ++j) { const float g = acc[ai][0][m][n][j] * rs, up = acc[ai][1][m][n][j] * rs; r[4 * n + j] = g * __builtin_amdgcn_rcpf(1.0f + __expf(-g)) * up; }
                u32x4 w; w.x = cvt_pk_bf16(r[0], r[1]); w.y = cvt_pk_bf16(r[2], r[3]); w.z = cvt_pk_bf16(r[4], r[5]); w.w = cvt_pk_bf16(r[6], r[7]);
                *(u32x4*)rowp = w; } }
    }
};

template <class Epi, bool ALIGN_EPI, bool SP2>
__device__ __forceinline__ void gemm_phase(LAS unsigned char* lds, const Gemm g, const StaticOrder& S, const Epi& E) {
    const int tid = threadIdx.x, wid = __builtin_amdgcn_readfirstlane(tid >> 6), lane = tid & 63, wr = wid >> 2, wc = wid & 3, fr = lane & 15, fq = lane >> 4;
    const int K = g.K, nt = K / BK;
    unsigned voffA[2], voffB[2];
#pragma unroll
    for (int i = 0; i < 2; ++i) { int R, C; stage_rc(tid * 16 + i * 8192, R, C); const int Rb = Epi::PERM ? ((R & ~31) + perm32(R & 31)) : R;
        voffA[i] = (unsigned)(R * g.lda + C) * 2u; voffB[i] = (unsigned)(Rb * g.ldb + C) * 2u; }
    const size_t kstep = (size_t)(BK * 2);
    const size_t hstepA = (size_t)HALF * g.lda * 2, hstepB = (size_t)HALF * g.ldb * 2;
    const size_t tstepA = 2 * hstepA, tstepB = 2 * hstepB;
    const unsigned ldsw = (unsigned)wid * 1024u;
    const int aoff = lds_byte(wr * 64 + fr, fq * 8), boff = lds_byte(wc * 32 + fr, fq * 8);
#define PG8_SA(b, h) (((b) * 2 + (h)) * HTB)
#define PG8_SB(b, h) ((4 + (b) * 2 + (h)) * HTB)
#define PG8_STAGE(bufoff, gbase, voff) do { _Pragma("unroll") for (int _i = 0; _i < 2; ++_i) \
        __builtin_amdgcn_global_load_lds((const unsigned*)((const char*)(gbase) + (voff)[_i]), (LAS unsigned*)(lds + (bufoff) + ldsw + _i * 8192), 16, 0, 0); } while (0)
#define PG8_LDA(dst, b, h) do { _Pragma("unroll") for (int m = 0; m < 4; ++m) _Pragma("unroll") for (int k = 0; k < 2; ++k) dst[m][k] = *(const LAS bf16x8*)(lds + PG8_SA(b, h) + aoff + m * 2048 + k * 1024); } while (0)
#define PG8_LDB(dst, b, h) do { _Pragma("unroll") for (int n = 0; n < 2; ++n) _Pragma("unroll") for (int k = 0; k < 2; ++k) dst[n][k] = *(const LAS bf16x8*)(lds + PG8_SB(b, h) + boff + n * 2048 + k * 1024); } while (0)
#define PG8_MMA(ai, bj, At, Bt) do { __builtin_amdgcn_s_setprio(1); _Pragma("unroll") for (int m = 0; m < 4; ++m) _Pragma("unroll") for (int n = 0; n < 2; ++n) _Pragma("unroll") for (int k = 0; k < 2; ++k) \
        acc[ai][bj][m][n] = __builtin_amdgcn_mfma_f32_16x16x32_bf16(Bt[n][k], At[m][k], acc[ai][bj][m][n], 0, 0, 0); __builtin_amdgcn_s_setprio(0); } while (0)
#define PG8_WAIT_V(n) asm volatile("s_waitcnt vmcnt(" #n ")" ::: "memory")
#define PG8_WAIT_L(n) asm volatile("s_waitcnt lgkmcnt(" #n ")" ::: "memory")
#define PG8_BAR __builtin_amdgcn_s_barrier()
#define PG8_SCHED __builtin_amdgcn_sched_barrier(0)
    Unit cur, nxt; int ui = 0;
    if (!S.next(0, cur)) return;
    f32x4 acc[2][2][4][2];
#pragma unroll
    for (int a = 0; a < 2; ++a)
#pragma unroll
        for (int b = 0; b < 2; ++b)
#pragma unroll
            for (int m = 0; m < 4; ++m)
#pragma unroll
                for (int n = 0; n < 2; ++n) acc[a][b][m][n] = (f32x4){0.f, 0.f, 0.f, 0.f};
    bf16x8 At[4][2], B0[2][2], B1[2][2];
    const char* cA = (const char*)g.A + (size_t)cur.pm * tstepA; const char* cB = (const char*)g.Bt + (size_t)cur.pn * tstepB;
    if constexpr (SP2) {
        PG8_STAGE(PG8_SB(0, 0), cB, voffB); PG8_STAGE(PG8_SB(0, 1), cB + hstepB, voffB); PG8_STAGE(PG8_SA(0, 0), cA, voffA); PG8_STAGE(PG8_SA(0, 1), cA + hstepA, voffA);
        if (wr == 1) PG8_BAR;
        PG8_WAIT_V(2); PG8_BAR;
        PG8_STAGE(PG8_SB(1, 0), cB + kstep, voffB); PG8_STAGE(PG8_SA(1, 0), cA + kstep, voffA); PG8_STAGE(PG8_SB(1, 1), cB + hstepB + kstep, voffB);
        PG8_WAIT_V(6); PG8_BAR;
    } else {
        PG8_STAGE(PG8_SB(0, 0), cB, voffB); PG8_STAGE(PG8_SA(0, 0), cA, voffA); PG8_STAGE(PG8_SB(0, 1), cB + hstepB, voffB); PG8_STAGE(PG8_SA(0, 1), cA + hstepA, voffA);
        if (wr == 1) PG8_BAR;
        PG8_WAIT_V(4); PG8_BAR;
        PG8_STAGE(PG8_SB(1, 0), cB + kstep, voffB); PG8_STAGE(PG8_SA(1, 0), cA + kstep, voffA); PG8_STAGE(PG8_SB(1, 1), cB + hstepB + kstep, voffB);
        PG8_WAIT_V(6); PG8_BAR;
    }
    for (;;) {
        const bool has_next = S.next(ui + 1, nxt);
        const char* nA = has_next ? (const char*)g.A + (size_t)nxt.pm * tstepA : cA; const char* nB = has_next ? (const char*)g.Bt + (size_t)nxt.pn * tstepB : cB;
        const int uh = cur.half;
#define PG8_MMF0(At, B0, B1) do { PG8_MMA(0, 0, At, B0); PG8_MMA(0, 1, At, B1); } while (0)
#define PG8_MMF1(At, B0, B1) do { PG8_MMA(1, 0, At, B0); PG8_MMA(1, 1, At, B1); } while (0)
#define PG8_MMN(At, B0, B1) do { } while (0)
#define PG8_KLOOP(MM0, MM1) \
        for (int t = 0; t < nt; t += 2) { \
            const bool last = (t == nt - 2); \
            const char* a1 = cA + (size_t)(t + 1) * kstep; \
            const char* a2 = last ? nA : cA + (size_t)(t + 2) * kstep; const char* b2 = last ? nB : cB + (size_t)(t + 2) * kstep; \
            const char* a3 = a2 + kstep; const char* b3 = b2 + kstep; \
            if constexpr (SP2) { \
            PG8_LDB(B0, 0, 0); PG8_LDB(B1, 0, 1); PG8_SCHED; PG8_LDA(At, 0, 0); PG8_STAGE(PG8_SA(1, 1), a1 + hstepA, voffA); \
            PG8_WAIT_V(8); PG8_WAIT_L(0); PG8_BAR; MM0(At, B0, B1); PG8_BAR; PG8_SCHED; \
            PG8_LDA(At, 0, 1); PG8_STAGE(PG8_SB(0, 0), b2, voffB); PG8_STAGE(PG8_SB(0, 1), b2 + hstepB, voffB); PG8_STAGE(PG8_SA(0, 0), a2, voffA); \
            PG8_WAIT_V(8); PG8_WAIT_L(0); PG8_BAR; MM1(At, B0, B1); PG8_BAR; PG8_SCHED; \
            PG8_LDB(B0, 1, 0); PG8_LDB(B1, 1, 1); PG8_SCHED; PG8_LDA(At, 1, 0); PG8_STAGE(PG8_SA(0, 1), a2 + hstepA, voffA); \
            PG8_WAIT_V(8); PG8_WAIT_L(0); PG8_BAR; MM0(At, B0, B1); PG8_BAR; PG8_SCHED; \
            PG8_LDA(At, 1, 1); PG8_STAGE(PG8_SB(1, 0), b3, voffB); PG8_STAGE(PG8_SB(1, 1), b3 + hstepB, voffB); PG8_STAGE(PG8_SA(1, 0), a3, voffA); \
            PG8_WAIT_V(8); PG8_WAIT_L(0); PG8_BAR; MM1(At, B0, B1); PG8_BAR; PG8_SCHED; \
            } else { \
            PG8_LDB(B0, 0, 0); PG8_SCHED; PG8_LDA(At, 0, 0); PG8_STAGE(PG8_SA(1, 1), a1 + hstepA, voffA); \
            PG8_WAIT_L(8); PG8_BAR; PG8_WAIT_L(0); PG8_MMA(0, 0, At, B0); PG8_BAR; PG8_SCHED; \
            PG8_LDB(B1, 0, 1); PG8_STAGE(PG8_SB(0, 0), b2, voffB); \
            PG8_BAR; PG8_WAIT_L(0); PG8_MMA(0, 1, At, B1); PG8_BAR; \
            PG8_LDA(At, 0, 1); PG8_STAGE(PG8_SA(0, 0), a2, voffA); \
            PG8_BAR; PG8_WAIT_L(0); PG8_MMA(1, 0, At, B0); PG8_BAR; PG8_SCHED; \
            PG8_STAGE(PG8_SB(0, 1), b2 + hstepB, voffB); \
            PG8_WAIT_V(6); PG8_BAR; PG8_MMA(1, 1, At, B1); PG8_BAR; \
            PG8_LDB(B0, 1, 0); PG8_SCHED; PG8_LDA(At, 1, 0); PG8_STAGE(PG8_SA(0, 1), a2 + hstepA, voffA); \
            PG8_WAIT_L(8); PG8_BAR; PG8_WAIT_L(0); PG8_MMA(0, 0, At, B0); PG8_BAR; PG8_SCHED; \
            PG8_LDB(B1, 1, 1); PG8_STAGE(PG8_SB(1, 0), b3, voffB); \
            PG8_BAR; PG8_WAIT_L(0); PG8_MMA(0, 1, At, B1); PG8_BAR; \
            PG8_LDA(At, 1, 1); PG8_STAGE(PG8_SA(1, 0), a3, voffA); \
            PG8_BAR; PG8_WAIT_L(0); PG8_MMA(1, 0, At, B0); PG8_BAR; PG8_SCHED; \
            PG8_STAGE(PG8_SB(1, 1), b3 + hstepB, voffB); \
            PG8_WAIT_V(6); PG8_BAR; PG8_MMA(1, 1, At, B1); PG8_BAR; \
            } \
        }
        if (uh < 0) { PG8_KLOOP(PG8_MMF0, PG8_MMF1) } else if (uh == 0) { PG8_KLOOP(PG8_MMF0, PG8_MMN) } else { PG8_KLOOP(PG8_MMN, PG8_MMF1) }
#undef PG8_KLOOP
#undef PG8_MMF0
#undef PG8_MMF1
#undef PG8_MMN
        if constexpr (ALIGN_EPI) { if (wr == 0) PG8_BAR; }
        E(acc, cur, wr, wc, fr, fq);
        if (!has_next) break;
#pragma unroll
        for (int a = 0; a < 2; ++a)
#pragma unroll
            for (int b = 0; b < 2; ++b)
#pragma unroll
                for (int m = 0; m < 4; ++m)
#pragma unroll
                    for (int n = 0; n < 2; ++n) acc[a][b][m][n] = (f32x4){0.f, 0.f, 0.f, 0.f};
        cur = nxt; cA = nA; cB = nB; ++ui;
        if constexpr (ALIGN_EPI) { if (wr == 1) PG8_BAR; }
    }
    PG8_WAIT_V(0);
    if constexpr (!ALIGN_EPI) { if (wr == 0) PG8_BAR; }
    PG8_BAR;
#undef PG8_SA
#undef PG8_SB
#undef PG8_STAGE
#undef PG8_LDA
#undef PG8_LDB
#undef PG8_MMA
#undef PG8_WAIT_V
#undef PG8_WAIT_L
#undef PG8_BAR
#undef PG8_SCHED
}
}

constexpr size_t SZ_WIN0 = (size_t)EVEN_IN * DM * 2, SZ_WOUT0 = (size_t)DM * DM * 2, SZ_WGU = (size_t)2 * FF * DM * 2, SZ_WD = (size_t)DM * FF * 2;
constexpr size_t SZ_WIN1 = (size_t)ODD_PAD * DM * 2, SZ_WOUT1 = (size_t)DM * DM * 2, SZ_WDSA = (size_t)3072 * 384 * 2, SZ_WUVT = (size_t)8 * 128 * 256 * 2;
constexpr size_t WS_CTL = 0, CTL_BYTES = 1u << 20, WS_BAR = WS_CTL + 896 * 1024, BAR_BYTES = 16384, WS_SSQ = WS_CTL + 512 * 1024, WS_QCNT = WS_CTL + 640 * 1024;
constexpr size_t WS_WIN1 = WS_CTL + CTL_BYTES, WS_WOUT1 = WS_WIN1 + SZ_WIN1, WS_WGU1 = WS_WOUT1 + SZ_WOUT1, WS_WD1 = WS_WGU1 + SZ_WGU, WS_WDSA = WS_WD1 + SZ_WD;
constexpr size_t WS_WUVT = WS_WDSA + SZ_WDSA;
constexpr size_t WS_B = WS_WUVT + SZ_WUVT;
constexpr size_t WS_WIN0 = WS_B, WS_WOUT0 = WS_WIN0 + SZ_WIN0, WS_WGU0 = WS_WOUT0 + SZ_WOUT0, WS_WD0 = WS_WGU0 + SZ_WGU, WS_B_END = WS_WD0 + SZ_WD;
constexpr size_t WS_MIX1 = WS_B, WS_QRAW = WS_MIX1 + (size_t)M * 2048 * 2, WS_QI = WS_QRAW + (size_t)M * 2048 * 2;
static_assert(WS_QI + (size_t)M * 1024 * 2 <= WS_B_END, "layer-1 overlay fits in the layer-0 weight region");
constexpr size_t WS_XN = WS_B_END;
constexpr size_t WS_Z = WS_XN + (size_t)M * DM * 2;
constexpr size_t WS_X1 = WS_Z + (size_t)M * EVEN_IN * 2;
constexpr size_t WS_RAW = WS_X1 + (size_t)M * DM * 4;
constexpr size_t WS_MIX0 = WS_RAW + (size_t)M * 1024 * 2;
constexpr size_t WS_KVN = WS_MIX0, WS_SEL = WS_KVN + (size_t)M * 256 * 2, WS_NSEL = WS_SEL + (size_t)M * 256 * 2, WS_MSCQ = WS_NSEL + (size_t)M * 4;
constexpr size_t WS_ROPE = WS_MIX0 + (size_t)M * DM * 2;
constexpr size_t WS_END = WS_ROPE + (size_t)2 * SEQ * 128 * 4;
static_assert(WS_MSCQ + (size_t)M * 4 <= WS_ROPE, "layer-1 small buffers fit in MIX0");
static_assert(WS_END <= 473360896ull, "workspace map exceeds the guaranteed d_ws size");

constexpr int LDS_BYTES = 163840;
constexpr int NPHASES = 17;

struct Args {
    const float* in[23];
    float* out; unsigned char* ws;
    int ph_lo, ph_hi, flags, pad;
};
enum { I_X = 0, I_LN_MIX, I_LN_FFN, I_WG, I_WU, I_WD, I_RELB, I_EV_WIN, I_EV_WOUT, I_SGU_LNG, I_SGU_LNB, I_SGU_WS, I_SGU_BS, I_OD_WIN, I_OD_WOUT, I_HG_LB, I_HG_NG,
       I_CQ_G, I_CKV_G, I_W_UQ, I_QN_G, I_W_QIDX, I_W_UV };

__device__ __forceinline__ f32x4 mma_tile(const LAS bf16* A, int lda, const LAS bf16* B, int ldb, int ksteps, f32x4 acc, int r, int g) {
    const LAS bf16* pa = A + r * lda + g * 8; const LAS bf16* pb = B + r * ldb + g * 8;
    for (int s = 0; s < ksteps; ++s) {
        const bf16x8 a = *(const LAS bf16x8*)(pa + s * 32); const bf16x8 b = *(const LAS bf16x8*)(pb + s * 32);
        acc = __builtin_amdgcn_mfma_f32_16x16x32_bf16(a, b, acc, 0, 0, 0);
    }
    return acc;
}


#define XB_TMO      128
#define XB_XCNT(j)  (256  + 64 * (j))
#define XB_XSUB(j)  (1280 + 64 * (j))
#define XB_XGEN(j)  (2304 + 64 * (j))
#define XB_TOP      3328
#define XB_TOPGEN   3392
#define XCD_BAR_WORDS 3456
#define XB_SPIN_CAP (1u << 20)
__device__ __forceinline__ unsigned xb_ld(unsigned* p)              { return __hip_atomic_load(p, __ATOMIC_RELAXED, __HIP_MEMORY_SCOPE_AGENT); }
__device__ __forceinline__ unsigned xb_add(unsigned* p, unsigned v) { return __hip_atomic_fetch_add(p, v, __ATOMIC_RELAXED, __HIP_MEMORY_SCOPE_AGENT); }
__device__ __forceinline__ unsigned xb_xcc_id() { return (unsigned)__builtin_amdgcn_s_getreg((3 << 11) | 20) & 0xFu; }
#define XB_SPIN(cond, bar) do { unsigned _sp = 0; while (cond) { __builtin_amdgcn_s_sleep(1); \
    if ((++_sp & 255u) == 0u) { if (xb_ld(&(bar)[XB_TMO])) break; if (_sp > XB_SPIN_CAP) { atomicAdd(&(bar)[XB_TMO], 1u); break; } } } } while (0)
struct XcdBarrier { unsigned* bar; unsigned x; volatile LAS unsigned* st; };
__device__ __forceinline__ XcdBarrier xcd_barrier_post(unsigned* bar, volatile LAS unsigned* st) {
    XcdBarrier b; b.bar = bar; b.x = xb_xcc_id(); b.st = st;
    if (threadIdx.x == 0) (void)xb_add(&bar[XB_XCNT(b.x)], 1u);
    return b;
}
__device__ __forceinline__ void xcd_barrier_complete(unsigned* bar, unsigned x, unsigned& nloc, unsigned& nx) {
    const unsigned G = gridDim.x * gridDim.y * gridDim.z;
    unsigned sum, cnt, mine, sp = 0u;
    for (;;) {
        sum = 0u; cnt = 0u; mine = 0u;
#pragma unroll
        for (unsigned j = 0; j < 16; ++j) { const unsigned c = xb_ld(&bar[XB_XCNT(j)]); sum += c; cnt += (c > 0u) ? 1u : 0u; mine = (j == x) ? c : mine; }
        if (sum == G) break;
        __builtin_amdgcn_s_sleep(1);
        if ((++sp & 255u) == 0u) { if (xb_ld(&bar[XB_TMO])) break; if (sp > XB_SPIN_CAP) { atomicAdd(&bar[XB_TMO], 1u); break; } }
    }
    nloc = mine > 0u ? mine : 1u; nx = cnt > 0u ? cnt : 1u;
}
__device__ __forceinline__ void xcd_barrier(const XcdBarrier& b) {
    asm volatile("s_waitcnt vmcnt(0)" ::: "memory");
    __syncthreads();
    if (threadIdx.x == 0) {
        unsigned* bar = b.bar;
        __builtin_amdgcn_s_waitcnt(0);
        unsigned nloc = b.st[0], nx = b.st[1];
        if (nloc == 0u) { xcd_barrier_complete(bar, b.x, nloc, nx); b.st[0] = nloc; b.st[1] = nx; }
        const unsigned old = xb_add(&bar[XB_XSUB(b.x)], 1u);
        const unsigned gen = old / nloc;
        if (old + 1u == (gen + 1u) * nloc) {
            __builtin_amdgcn_fence(__ATOMIC_RELEASE, "agent");
            asm volatile("s_waitcnt vmcnt(0)" ::: "memory");
            const unsigned og = xb_add(&bar[XB_TOP], 1u);
            const unsigned tg = og / nx;
            if (og + 1u == (tg + 1u) * nx) xb_add(&bar[XB_TOPGEN], 1u);
            else XB_SPIN(xb_ld(&bar[XB_TOPGEN]) == tg, bar);
            __builtin_amdgcn_fence(__ATOMIC_ACQUIRE, "agent");
            xb_add(&bar[XB_XGEN(b.x)], 1u);
            asm volatile("s_waitcnt vmcnt(0)" ::: "memory");
        } else {
            XB_SPIN(xb_ld(&bar[XB_XGEN(b.x)]) == gen, bar);
            __builtin_amdgcn_fence(__ATOMIC_ACQUIRE, "agent");
            asm volatile("s_waitcnt vmcnt(0)" ::: "memory");
        }
    }
    __syncthreads();
}

struct TrD { const float* W; const float* ks; bf16* WT; int N, ldd, row_off, mode, k0, n0; };
__device__ __forceinline__ void tr_set(TrD& d, const float* W, int N, bf16* WT, int ldd, int row_off, int mode, const float* ks, int item) {
    const int nblk = (N + 63) >> 6, kb = item / nblk, nb = item - kb * nblk;
    d.W = W; d.ks = ks; d.WT = WT; d.N = N; d.ldd = ldd; d.row_off = row_off; d.mode = mode; d.k0 = 64 * kb; d.n0 = 64 * nb;
}
__device__ __forceinline__ void tr_load(const TrD& d, f32x4 (&R)[16], int lane) {
    const int n = d.n0 + 4 * (lane & 15); const bool ok = n < d.N;
    const float* p = d.W + (size_t)(d.k0 + (lane >> 4)) * d.N + n;
#pragma unroll
    for (int i = 0; i < 16; ++i) R[i] = ok ? *(const f32x4*)(p + (size_t)(4 * i) * d.N) : (f32x4){0.f, 0.f, 0.f, 0.f};
}
__device__ __forceinline__ void tr_finish(const TrD& d, const f32x4 (&R)[16], LAS float* scr, int lane) {
#pragma unroll
    for (int i = 0; i < 16; ++i) { const int kk = 4 * i + (lane >> 4); *(LAS f32x4*)(scr + kk * 68 + 4 * (kk >> 3) + 4 * (lane & 15)) = R[i]; }
    LDS_WAIT(); asm volatile("" ::: "memory");
    const int c = lane & 7; const LAS float* s = scr + (8 * c) * 68 + 4 * c;
    f32x4 g0 = (f32x4){1.f, 1.f, 1.f, 1.f}, g1 = g0;
    if (d.ks) { g0 = *(const f32x4*)(d.ks + d.k0 + 8 * c); g1 = *(const f32x4*)(d.ks + d.k0 + 8 * c + 4); }
#pragma unroll
    for (int j = 0; j < 8; ++j) { const int nl = (lane >> 3) + 8 * j, n = d.n0 + nl;
        u32x4 o; o.x = pk2(s[0 * 68 + nl] * g0.x, s[1 * 68 + nl] * g0.y); o.y = pk2(s[2 * 68 + nl] * g0.z, s[3 * 68 + nl] * g0.w);
        o.z = pk2(s[4 * 68 + nl] * g1.x, s[5 * 68 + nl] * g1.y); o.w = pk2(s[6 * 68 + nl] * g1.z, s[7 * 68 + nl] * g1.w);
        const int mr = (d.mode == 0) ? n : (256 * (n >> 7) + (n & 127) + (d.mode == 2 ? 128 : 0));
        if (n < d.N) *(u32x4*)(d.WT + (size_t)(d.row_off + mr) * d.ldd + d.k0 + 8 * c) = o; }
    LDS_WAIT(); asm volatile("" ::: "memory");
}
__device__ __forceinline__ void rms_row_to_bf16(const float* xrow, const float* gain, bf16* orow, int lane) {
    const f32x4* xr = (const f32x4*)xrow + lane; const f32x4* gr = (const f32x4*)gain + lane;
    f32x4 v[8]; float s = 0.f;
#pragma unroll
    for (int j = 0; j < 8; ++j) { v[j] = xr[64 * j]; s += (v[j].x * v[j].x + v[j].y * v[j].y) + (v[j].z * v[j].z + v[j].w * v[j].w); }
    const float rstd = __builtin_amdgcn_rsqf(wave_sum(s) * (1.0f / DM) + EPS);
    u32x2* o8 = (u32x2*)orow + lane;
#pragma unroll
    for (int j = 0; j < 8; ++j) { const f32x4 gg = gr[64 * j]; u32x2 w; w.x = pk2(v[j].x * rstd * gg.x, v[j].y * rstd * gg.y); w.y = pk2(v[j].z * rstd * gg.z, v[j].w * rstd * gg.w); o8[64 * j] = w; }
}
__device__ __forceinline__ void norm_rows(const float* X, const float* gain, bf16* XN, int gw, int NGW, int lane) {
    asm volatile("" : "+v"(lane));
    for (int m = gw; m < M; m += NGW) rms_row_to_bf16(X + (size_t)m * DM, gain, XN + (size_t)m * DM, lane);
}


template <int SET>
__device__ __forceinline__ bool conv_desc(const Args& a, int r, TrD& d) {
    unsigned char* ws = a.ws;
    constexpr int J_IN0 = (DM / 64) * (EVEN_IN / 64), J_SQ = (DM / 64) * (DM / 64), J_GU = (DM / 64) * (FF / 64), J_DN = (FF / 64) * (DM / 64), J_IN1 = (DM / 64) * ((ODD_IN + 63) / 64),
                  J_UQ = (384 / 64) * (2048 / 64), J_QI = (384 / 64) * (1024 / 64), J_UV = 8 * (256 / 64) * (128 / 64);
    const float* wg = a.in[I_WG]; const float* wu = a.in[I_WU]; const float* wd = a.in[I_WD];
    if (r < 0) return false;
    if (SET == 0) { if (r >= J_IN0) return false; tr_set(d, a.in[I_EV_WIN], EVEN_IN, (bf16*)(ws + WS_WIN0), DM, 0, 0, nullptr, r); return true; }
    if (SET == 1) {
        if (r < J_SQ) { tr_set(d, a.in[I_EV_WOUT], DM, (bf16*)(ws + WS_WOUT0), DM, 0, 0, nullptr, r); return true; } r -= J_SQ;
        if (r < J_GU) { tr_set(d, wg, FF, (bf16*)(ws + WS_WGU0), DM, 0, 1, a.in[I_LN_FFN], r); return true; } r -= J_GU;
        if (r < J_GU) { tr_set(d, wu, FF, (bf16*)(ws + WS_WGU0), DM, 0, 2, a.in[I_LN_FFN], r); return true; } r -= J_GU;
        if (r < J_DN) { tr_set(d, wd, DM, (bf16*)(ws + WS_WD0), FF, 0, 0, nullptr, r); return true; } r -= J_DN;
        if (r < J_IN1) { tr_set(d, a.in[I_OD_WIN], ODD_IN, (bf16*)(ws + WS_WIN1), DM, 0, 0, a.in[I_LN_MIX] + DM, r); return true; } r -= J_IN1;
        if (r < J_UQ) { tr_set(d, a.in[I_W_UQ], 2048, (bf16*)(ws + WS_WDSA), 384, 0, 0, a.in[I_CQ_G], r); return true; } r -= J_UQ;
        if (r < J_QI) { tr_set(d, a.in[I_W_QIDX], 1024, (bf16*)(ws + WS_WDSA), 384, 2048, 0, a.in[I_CQ_G], r); return true; }
        return false; }
    if (SET == 3) {
        if (r < J_GU) { tr_set(d, wg + (size_t)DM * FF, FF, (bf16*)(ws + WS_WGU1), DM, 0, 1, a.in[I_LN_FFN] + DM, r); return true; } r -= J_GU;
        if (r < J_GU) { tr_set(d, wu + (size_t)DM * FF, FF, (bf16*)(ws + WS_WGU1), DM, 0, 2, a.in[I_LN_FFN] + DM, r); return true; }
        return false; }
    if (r < J_DN) { tr_set(d, wd + (size_t)FF * DM, DM, (bf16*)(ws + WS_WD1), FF, 0, 0, nullptr, r); return true; } r -= J_DN;
    if (r < J_SQ) { tr_set(d, a.in[I_OD_WOUT], DM, (bf16*)(ws + WS_WOUT1), DM, 0, 0, nullptr, r); return true; } r -= J_SQ;
    if (r < J_UV) { const int h = r >> 3; tr_set(d, a.in[I_W_UV] + (size_t)h * 256 * 128, 128, (bf16*)(ws + WS_WUVT), 256, 128 * h, 0, nullptr, r & 7); return true; }
    return false;
}
template <int SET>
__device__ __forceinline__ void conv_set(const Args& a, LAS unsigned char* lds, int tid, int lane, int wave, int gwv, int ngw, int gth, int nth) {
    LAS float* scr = (LAS float*)(lds + wave * 17920);
    asm volatile("" : "+v"(lane));
    TrD d0, d1; f32x4 R0[16], R1[16];
    int it = gwv; bool v0 = conv_desc<SET>(a, it, d0);
    if (v0) tr_load(d0, R0, lane);
    while (v0) {
        const bool v1 = conv_desc<SET>(a, it + ngw, d1);
        if (v1) tr_load(d1, R1, lane);
        tr_finish(d0, R0, scr, lane);
        if (!v1) break;
        it += 2 * ngw; v0 = conv_desc<SET>(a, it, d0);
        if (v0) tr_load(d0, R0, lane);
        tr_finish(d1, R1, scr, lane);
    }
    if (SET == 1) {
        const size_t n16 = (size_t)(ODD_PAD - ODD_IN) * DM * 2 / 16; u32x4* p = (u32x4*)((bf16*)(a.ws + WS_WIN1) + (size_t)ODD_IN * DM);
        for (size_t i = gth; i < n16; i += nth) p[i] = (u32x4){0u, 0u, 0u, 0u}; }
}
__device__ __forceinline__ void p0_prologue(const Args& a, LAS unsigned char* lds, int tid, int lane, int wave, int G) {
    unsigned char* ws = a.ws;
    const int gw = blockIdx.x * 8 + wave, NGW = G * 8;
    conv_set<0>(a, lds, tid, lane, wave, gw, NGW, blockIdx.x * 512 + tid, G * 512);
    for (int i = blockIdx.x * 512 + tid; i < 3 * M; i += G * 512) ((float*)(ws + WS_SSQ))[i] = 0.f;
    if (blockIdx.x == 0 && tid < 64) ((unsigned*)(ws + WS_QCNT))[tid] = 0u;
    { float* ct = (float*)(ws + WS_ROPE); float* st = ct + (size_t)SEQ * 128;
      for (int u = blockIdx.x * 512 + tid; u < SEQ * 128; u += G * 512) { const int t = u >> 7, i = u & 127;
          const float inv = powf(10000.0f, -(float)(2 * i) / 256.0f); const float ang = (float)t * inv; float s, c; sincosf(ang, &s, &c); ct[u] = c; st[u] = s; } }
    norm_rows(a.in[I_X], a.in[I_LN_MIX], (bf16*)(ws + WS_XN), gw, NGW, lane);
}

constexpr size_t WS_QE = WS_X1, WS_KST = WS_QE + (size_t)16 * 1024 * 1024, WS_VTT = WS_KST + (size_t)16 * 1024 * 1024, WS_INTRA = WS_VTT + (size_t)16 * 1024 * 1024, WS_DEC = WS_CTL;
constexpr size_t WS_OBUF = WS_X1;
static_assert(WS_INTRA + (size_t)M * 1024 * 2 <= WS_X1 + (size_t)M * DM * 4 && (size_t)1024 * 128 * 4 <= CTL_BYTES, "scan scratch fits in X1 / CTL");

template <int DK, bool HG>
__device__ __forceinline__ void prep_item(const Args& a, LAS unsigned char* lds, int item, int tid, int lane, int wave) {
    constexpr int DV = DK, LQ = DK + 8, LT = 72, KS = DK / 32, NH = HG ? 8 : 4;
    constexpr int O_QE = 0, O_KE = O_QE + 64 * LQ * 2, O_KST = O_KE + 64 * LQ * 2, O_VT = O_KST + DK * LT * 2, O_P = O_VT + DV * LT * 2, O_TAB = O_P + 64 * LT * 2;
    static_assert(O_TAB + 4096 <= LDS_BYTES, "prep LDS map");
    LAS bf16* Qe = (LAS bf16*)(lds + O_QE); LAS bf16* Ke = (LAS bf16*)(lds + O_KE); LAS bf16* KsT = (LAS bf16*)(lds + O_KST); LAS bf16* VT = (LAS bf16*)(lds + O_VT);
    LAS bf16* Pm = (LAS bf16*)(lds + O_P); LAS float* TAB = (LAS float*)(lds + O_TAB);
    const int r = lane & 15, g = lane >> 4;
    const int c = item & 63, bh = item >> 6, b = bh / NH, h = bh % NH;
    const bf16* Z = (const bf16*)(a.ws + WS_Z);
    const int ldz = HG ? ODD_PAD : EVEN_IN, cq = HG ? (Z1_HQ + h * 128) : (h * 256), ck = HG ? (Z1_HF + h * 128) : (1024 + h * 256), cv = HG ? (Z1_HI + h * 128) : (2048 + h * 256);
    const size_t t0 = (size_t)b * SEQ + (size_t)c * 64;
    bf16* RAW = (bf16*)(a.ws + WS_INTRA);
    if (!HG) { const float lgam = log2f(1.0f - exp2f(-5.0f - (float)h)); if (tid < 65) TAB[tid] = exp2f(lgam * (float)tid); }
#pragma unroll
    for (int k = 0; k < DV / 64; ++k) { const int eg = wave + 8 * k, i = lane; const u32x4 rv = *(const u32x4*)(Z + (t0 + i) * ldz + cv + 8 * eg);
#pragma unroll
        for (int e = 0; e < 4; ++e) { VT[(8 * eg + 2 * e) * LT + i] = (bf16)(rv[e] & 0xffffu); VT[(8 * eg + 2 * e + 1) * LT + i] = (bf16)(rv[e] >> 16); } }
    if (!HG) {
        __syncthreads();
#pragma unroll
        for (int k = 0; k < 2; ++k) { const int d0 = 8 * (wave + 8 * k), i = lane; const bf16* zr = Z + (t0 + i) * ldz;
            const u32x4 rq1 = *(const u32x4*)(zr + cq + d0), rq2 = *(const u32x4*)(zr + cq + 128 + d0), rk1 = *(const u32x4*)(zr + ck + d0), rk2 = *(const u32x4*)(zr + ck + 128 + d0);
            const float* cp = (const float*)(a.ws + WS_ROPE) + (size_t)(c * 64 + i) * 128 + d0; const float* sp = cp + (size_t)SEQ * 128;
            const f32x4 c0 = *(const f32x4*)cp, c1 = *(const f32x4*)(cp + 4), s0 = *(const f32x4*)sp, s1 = *(const f32x4*)(sp + 4);
            const float zeta = TAB[63 - i];
            float q1[8], q2[8], k1[8], k2[8], cs[8], sn[8];
#pragma unroll
            for (int e = 0; e < 4; ++e) { q1[2 * e] = bflo(rq1[e]); q1[2 * e + 1] = bfhi(rq1[e]); q2[2 * e] = bflo(rq2[e]); q2[2 * e + 1] = bfhi(rq2[e]);
                k1[2 * e] = bflo(rk1[e]); k1[2 * e + 1] = bfhi(rk1[e]); k2[2 * e] = bflo(rk2[e]); k2[2 * e + 1] = bfhi(rk2[e]);
                cs[e] = c0[e]; cs[4 + e] = c1[e]; sn[e] = s0[e]; sn[4 + e] = s1[e]; }
            float qa[8], qb[8], ka[8], kb[8];
#pragma unroll
            for (int e = 0; e < 8; ++e) { qa[e] = q1[e] * cs[e] - q2[e] * sn[e]; qb[e] = q1[e] * sn[e] + q2[e] * cs[e];
                ka[e] = (k1[e] * cs[e] - k2[e] * sn[e]) * 0.0625f; kb[e] = (k1[e] * sn[e] + k2[e] * cs[e]) * 0.0625f; }
            u32x4 w;
            w.x = pk2(qa[0], qa[1]); w.y = pk2(qa[2], qa[3]); w.z = pk2(qa[4], qa[5]); w.w = pk2(qa[6], qa[7]); *(LAS u32x4*)(Qe + i * LQ + d0) = w;
            w.x = pk2(qb[0], qb[1]); w.y = pk2(qb[2], qb[3]); w.z = pk2(qb[4], qb[5]); w.w = pk2(qb[6], qb[7]); *(LAS u32x4*)(Qe + i * LQ + 128 + d0) = w;
            w.x = pk2(ka[0], ka[1]); w.y = pk2(ka[2], ka[3]); w.z = pk2(ka[4], ka[5]); w.w = pk2(ka[6], ka[7]); *(LAS u32x4*)(Ke + i * LQ + d0) = w;
            w.x = pk2(kb[0], kb[1]); w.y = pk2(kb[2], kb[3]); w.z = pk2(kb[4], kb[5]); w.w = pk2(kb[6], kb[7]); *(LAS u32x4*)(Ke + i * LQ + 128 + d0) = w;
#pragma unroll
            for (int e = 0; e < 8; ++e) { KsT[(d0 + e) * LT + i] = f2bf1(ka[e] * zeta); KsT[(128 + d0 + e) * LT + i] = f2bf1(kb[e] * zeta); }
        }
    } else {
        const int d = tid & 127, seg = tid >> 7;
        const float l0 = a.in[I_HG_LB][h * 128 + d], l1 = a.in[I_HG_LB][1024 + h * 128 + d]; const float lb = __builtin_amdgcn_rcpf(1.0f + __expf(l0 - l1));
        unsigned rfq[16];
#pragma unroll
        for (int tt = 0; tt < 16; ++tt) { const bf16* zr = Z + (t0 + 16 * seg + tt) * ldz; rfq[tt] = (unsigned)zr[ck + d] | ((unsigned)zr[cq + d] << 16); }
        float cs[16], om[16]; float run = 0.f;
#pragma unroll
        for (int tt = 0; tt < 16; ++tt) { const float fl = bflo(rfq[tt]); const float sg = __builtin_amdgcn_rcpf(1.0f + __expf(-fl)); const float f = lb + (1.0f - lb) * sg;
            om[tt] = (1.0f - lb) * (1.0f - sg); run += __logf(f); cs[tt] = run; }
        TAB[256 + seg * 128 + d] = run;
        __syncthreads();
        float off = 0.f, tot = 0.f;
#pragma unroll
        for (int s2 = 0; s2 < 4; ++s2) { const float v = TAB[256 + s2 * 128 + d]; tot += v; if (s2 < seg) off += v; }
        if (seg == 0) TAB[d] = __expf(tot);
        float ks[16];
#pragma unroll
        for (int tt = 0; tt < 16; ++tt) { const float bc = fmaxf(off + cs[tt], -80.0f); const float qv = bfhi(rfq[tt]); const float qs = qv * __builtin_amdgcn_rcpf(1.0f + __expf(-qv));
            const int t = 16 * seg + tt;
            Qe[t * LQ + d] = f2bf1(qs * __expf(bc)); Ke[t * LQ + d] = f2bf1(om[tt] * __expf(-bc)); ks[tt] = om[tt] * __expf(fmaxf(tot, -80.0f) - bc); }
        u32x4 w;
        w.x = pk2(ks[0], ks[1]); w.y = pk2(ks[2], ks[3]); w.z = pk2(ks[4], ks[5]); w.w = pk2(ks[6], ks[7]); *(LAS u32x4*)(KsT + d * LT + 16 * seg) = w;
        w.x = pk2(ks[8], ks[9]); w.y = pk2(ks[10], ks[11]); w.z = pk2(ks[12], ks[13]); w.w = pk2(ks[14], ks[15]); *(LAS u32x4*)(KsT + d * LT + 16 * seg + 8) = w;
    }
    __syncthreads();
#pragma unroll
    for (int tt = 0; tt < 2; ++tt) { const int t = 2 * wave + tt, ti = t >> 2, tj = t & 3;
        f32x4 s = mma_tile(Ke + 16 * tj * LQ, LQ, Qe + 16 * ti * LQ, LQ, KS, (f32x4){0.f, 0.f, 0.f, 0.f}, r, g);
        const int i = 16 * ti + r;
#pragma unroll
        for (int jj = 0; jj < 4; ++jj) { const int j = 16 * tj + 4 * g + jj;
            if (!HG) { const int dd = i > j ? i - j : j - i; s[jj] *= TAB[dd]; } else { if (j > i) s[jj] = 0.f; } }
        u32x2 w; w.x = pk2(s[0], s[1]); w.y = pk2(s[2], s[3]); *(LAS u32x2*)(Pm + i * LT + 16 * tj + 4 * g) = w; }
    __syncthreads();
#pragma unroll
    for (int k = 0; k < DV / 32; ++k) { const int t = wave + 8 * k, ti = t & 3, te = t >> 2;
        const f32x4 o = mma_tile(VT + 16 * te * LT, LT, Pm + 16 * ti * LT, LT, 2, (f32x4){0.f, 0.f, 0.f, 0.f}, r, g);
        u32x2 w; w.x = pk2(o[0], o[1]); w.y = pk2(o[2], o[3]);
        *(u32x2*)(RAW + (t0 + 16 * ti + r) * 1024 + h * DV + 16 * te + 4 * g) = w; }
    { bf16* QEg = (bf16*)(a.ws + WS_QE) + (size_t)item * 64 * DK; bf16* KSTg = (bf16*)(a.ws + WS_KST) + (size_t)item * DK * 64; bf16* VTTg = (bf16*)(a.ws + WS_VTT) + (size_t)item * DV * 64;
#pragma unroll
      for (int k = 0; k < DK / 64; ++k) { const int u = tid + 512 * k; const int i = u / (DK / 8), cc = u % (DK / 8);
          *(u32x4*)(QEg + (size_t)u * 8) = *(const LAS u32x4*)(Qe + i * LQ + 8 * cc);
          const int d = u >> 3, c8 = u & 7;
          *(u32x4*)(KSTg + (size_t)u * 8) = *(const LAS u32x4*)(KsT + d * LT + 8 * c8);
          *(u32x4*)(VTTg + (size_t)u * 8) = *(const LAS u32x4*)(VT + d * LT + 8 * c8); }
      if (HG && tid < 128) ((float*)(a.ws + WS_DEC))[(size_t)item * 128 + tid] = TAB[tid]; }
    __syncthreads();
}

template <int DK, bool HG>
__device__ __forceinline__ void scan_item(const Args& a, LAS unsigned char* lds, int item, int tid, int lane, int wave) {
    constexpr int DV = DK, LQ = DK + 8, LT = 72, KS = DK / 32, DT = DK / 128, NH = HG ? 8 : 4, NSL = DV / 32, NU = DK / 64;
    constexpr int O_QE = 0, O_KST = O_QE + 64 * LQ * 2, O_VT = O_KST + DK * LT * 2, O_STB = O_VT + 32 * LT * 2, O_TAB = O_STB + 32 * LQ * 2;
    LAS bf16* Qe = (LAS bf16*)(lds + O_QE); LAS bf16* KsT = (LAS bf16*)(lds + O_KST); LAS bf16* VT = (LAS bf16*)(lds + O_VT);
    LAS bf16* STb = (LAS bf16*)(lds + O_STB); LAS float* TAB = (LAS float*)(lds + O_TAB);
    const int r = lane & 15, g = lane >> 4;
    constexpr int NBH = 64 / NSL;
    const int bh = item % NBH, sl = item / NBH, b = bh / NH, h = bh % NH;
    bf16* RAW = (bf16*)(a.ws + WS_RAW);
    const bf16* QEg = (const bf16*)(a.ws + WS_QE) + (size_t)bh * 64 * 64 * DK; const bf16* KSTg = (const bf16*)(a.ws + WS_KST) + (size_t)bh * 64 * DK * 64;
    const bf16* VTTg = (const bf16*)(a.ws + WS_VTT) + (size_t)bh * 64 * DV * 64 + (size_t)sl * 32 * 64; const float* DECg = (const float*)(a.ws + WS_DEC) + (size_t)bh * 64 * 128;
    if (!HG) { const float lgam = log2f(1.0f - exp2f(-5.0f - (float)h)); if (tid < 65) TAB[tid] = exp2f(lgam * (float)tid); }
    f32x4 st[DT][2];
#pragma unroll
    for (int dt = 0; dt < DT; ++dt) { st[dt][0] = (f32x4){0.f, 0.f, 0.f, 0.f}; st[dt][1] = (f32x4){0.f, 0.f, 0.f, 0.f}; }
    const int dbase = wave * (DK / 8), ti = wave >> 1, te = wave & 1;
    const size_t tok0 = (size_t)b * SEQ;
    bf16* outp = RAW + (tok0 + 16 * ti + r) * 1024 + h * DV + sl * 32 + 16 * te + 4 * g;
    const bf16* inp = (const bf16*)(a.ws + WS_INTRA) + (tok0 + 16 * ti + r) * 1024 + h * DV + sl * 32 + 16 * te + 4 * g;
    u32x4 rqeA[NU], rksA[NU], rvtA, rqeB[NU], rksB[NU], rvtB; u32x2 rinA, rinB; f32x4 rdecA[DT], rdecB[DT];
#define SCAN_LOAD(c_, rqe, rks, rvt, rin, rdec) do { \
        _Pragma("unroll") for (int k = 0; k < NU; ++k) { const int u = tid + 512 * k; \
            rqe[k] = *(const u32x4*)(QEg + (size_t)(c_) * 64 * DK + (size_t)u * 8); rks[k] = *(const u32x4*)(KSTg + (size_t)(c_) * DK * 64 + (size_t)u * 8); } \
        if (tid < 256) rvt = *(const u32x4*)(VTTg + (size_t)(c_) * DV * 64 + (size_t)tid * 8); \
        rin = *(const u32x2*)(inp + (size_t)(c_) * 64 * 1024); \
        if (HG) { _Pragma("unroll") for (int dt = 0; dt < DT; ++dt) rdec[dt] = *(const f32x4*)(DECg + (size_t)(c_) * 128 + dbase + 16 * dt + 4 * g); } \
    } while (0)
#define SCAN_STEP(c_, rqe, rks, rvt, rin, rdec) do { \
          \
        _Pragma("unroll") for (int k = 0; k < NU; ++k) { const int u = tid + 512 * k; const int i = u / (DK / 8), cc = u % (DK / 8); \
            *(LAS u32x4*)(Qe + i * LQ + 8 * cc) = rqe[k]; *(LAS u32x4*)(KsT + (u >> 3) * LT + 8 * (u & 7)) = rks[k]; } \
        if (tid < 256) *(LAS u32x4*)(VT + (tid >> 3) * LT + 8 * (tid & 7)) = rvt; \
        _Pragma("unroll") for (int dt = 0; dt < DT; ++dt) \
            _Pragma("unroll") for (int et = 0; et < 2; ++et) { u32x2 w; w.x = pk2(st[dt][et][0], st[dt][et][1]); w.y = pk2(st[dt][et][2], st[dt][et][3]); \
                *(LAS u32x2*)(STb + (16 * et + r) * LQ + dbase + 16 * dt + 4 * g) = w; } \
        const u32x2 inx = rin; f32x4 dec[DT]; \
        _Pragma("unroll") for (int dt = 0; dt < DT; ++dt) dec[dt] = HG ? rdec[dt] : (f32x4){0.f, 0.f, 0.f, 0.f}; \
        LDS_BAR(); \
        if ((c_) + 2 < 64) SCAN_LOAD((c_) + 2, rqe, rks, rvt, rin, rdec); \
          \
        const f32x4 accc = mma_tile(STb + 16 * te * LQ, LQ, Qe + 16 * ti * LQ, LQ, KS, (f32x4){0.f, 0.f, 0.f, 0.f}, r, g); \
        { const float xi = HG ? 1.0f : TAB[16 * ti + r + 1]; \
          u32x2 w; w.x = pk2(bflo(inx.x) + xi * accc[0], bfhi(inx.x) + xi * accc[1]); w.y = pk2(bflo(inx.y) + xi * accc[2], bfhi(inx.y) + xi * accc[3]); \
          *(u32x2*)(outp + (size_t)(c_) * 64 * 1024) = w; } \
          \
        const float g64 = HG ? 1.0f : TAB[64]; \
        _Pragma("unroll") for (int dt = 0; dt < DT; ++dt) \
            _Pragma("unroll") for (int et = 0; et < 2; ++et) { const int d0 = dbase + 16 * dt; \
                const f32x4 dd = HG ? dec[dt] : (f32x4){g64, g64, g64, g64}; \
                st[dt][et] = mma_tile(KsT + d0 * LT, LT, VT + 16 * et * LT, LT, 2, st[dt][et] * dd, r, g); } \
        LDS_BAR(); \
    } while (0)
    SCAN_LOAD(0, rqeA, rksA, rvtA, rinA, rdecA);
    SCAN_LOAD(1, rqeB, rksB, rvtB, rinB, rdecB);
    __syncthreads();
    for (int c = 0; c < 64; c += 2) {
        SCAN_STEP(c, rqeA, rksA, rvtA, rinA, rdecA);
        SCAN_STEP(c + 1, rqeB, rksB, rvtB, rinB, rdecB);
    }
#undef SCAN_STEP
#undef SCAN_LOAD
    __syncthreads();
}

__device__ __forceinline__ void sgu_item(const Args& a, LAS unsigned char* lds, int item, int tid, int lane, int wave) {
    constexpr int LW = 136;
    constexpr int O_W = 0, O_V = O_W + 128 * LW * 2, O_ST = O_V + 256 * LW * 2;
    LAS bf16* Wm = (LAS bf16*)(lds + O_W); LAS bf16* VnT = (LAS bf16*)(lds + O_V); LAS float* ST = (LAS float*)(lds + O_ST);
    const int win = item >> 2, grp = item & 3, r = lane & 15, g = lane >> 4;
    const bf16* Z = (const bf16*)(a.ws + WS_Z); bf16* MIX0 = (bf16*)(a.ws + WS_MIX0);
    const size_t tok0 = (size_t)win * 128;
    { const float* ws_ = a.in[I_SGU_WS] + (size_t)grp * 128 * 128;
      for (int u = tid; u < 128 * 16; u += 512) { const int i = u >> 4, j0 = (u & 15) * 8;
          const f32x4 w0 = *(const f32x4*)(ws_ + i * 128 + j0), w1 = *(const f32x4*)(ws_ + i * 128 + j0 + 4);
          const bool ok = (j0 >> 6) <= (i >> 6);
          u32x4 o; o.x = ok ? pk2(w0.x, w0.y) : 0u; o.y = ok ? pk2(w0.z, w0.w) : 0u; o.z = ok ? pk2(w1.x, w1.y) : 0u; o.w = ok ? pk2(w1.z, w1.w) : 0u;
          *(LAS u32x4*)(Wm + i * LW + j0) = o; } }
#pragma unroll 1
    for (int half = 0; half < 4; ++half) {
        u32x4 p0[4], p1[4];
#pragma unroll
        for (int tt = 0; tt < 4; ++tt) { const int j = wave * 16 + half * 4 + tt; const bf16* zr = Z + (tok0 + j) * EVEN_IN + 5120;
            p0[tt] = *(const u32x4*)(zr + lane * 8); p1[tt] = *(const u32x4*)(zr + 512 + lane * 8); }
        __builtin_amdgcn_sched_barrier(0);
#pragma unroll
        for (int tt = 0; tt < 4; ++tt) { const int j = wave * 16 + half * 4 + tt;
            float x[16];
#pragma unroll
            for (int e = 0; e < 4; ++e) { x[2 * e] = bflo(p0[tt][e]); x[2 * e + 1] = bfhi(p0[tt][e]); x[8 + 2 * e] = bflo(p1[tt][e]); x[8 + 2 * e + 1] = bfhi(p1[tt][e]); }
            float s = 0.f;
#pragma unroll
            for (int e = 0; e < 16; ++e) s += x[e];
            const float mean = wave_sum(s) * (1.0f / 1024.0f); float q = 0.f;
#pragma unroll
            for (int e = 0; e < 16; ++e) { const float dd = x[e] - mean; q += dd * dd; }
            const float var = wave_sum(q) * (1.0f / 1024.0f);
            if (lane == 0) { ST[2 * j] = mean; ST[2 * j + 1] = __builtin_amdgcn_rsqf(var + EPS); } } }
    __syncthreads();
    { const float* lng = a.in[I_SGU_LNG] + 256 * grp; const float* lnb = a.in[I_SGU_LNB] + 256 * grp;
      u32x4 pv[8];
#pragma unroll
      for (int k = 0; k < 8; ++k) { const int u = tid + 512 * k; const int j = u & 127, c0 = (u >> 7) * 8; pv[k] = *(const u32x4*)(Z + (tok0 + j) * EVEN_IN + 5120 + 256 * grp + c0); }
      __builtin_amdgcn_sched_barrier(0);
#pragma unroll
      for (int k = 0; k < 8; ++k) { const int u = tid + 512 * k; const int j = u & 127, c0 = (u >> 7) * 8; const u32x4 p = pv[k];
          const float mean = ST[2 * j], rstd = ST[2 * j + 1];
#pragma unroll
          for (int e = 0; e < 4; ++e) { const float x0 = (bflo(p[e]) - mean) * rstd * lng[c0 + 2 * e] + lnb[c0 + 2 * e], x1 = (bfhi(p[e]) - mean) * rstd * lng[c0 + 2 * e + 1] + lnb[c0 + 2 * e + 1];
              VnT[(c0 + 2 * e) * LW + j] = f2bf1(x0); VnT[(c0 + 2 * e + 1) * LW + j] = f2bf1(x1); } } }
    u32x2 upv[2][8];
#pragma unroll
    for (int q = 0; q < 2; ++q)
#pragma unroll
        for (int it = 0; it < 8; ++it) upv[q][it] = *(const u32x2*)(Z + (tok0 + 16 * it + r) * EVEN_IN + 4096 + 256 * grp + 16 * (2 * wave + q) + 4 * g);
    __syncthreads();
    const float* bs = a.in[I_SGU_BS] + 128 * grp;
#pragma unroll
    for (int q = 0; q < 2; ++q)
#pragma unroll
        for (int it = 0; it < 8; ++it) { const int ct = 2 * wave + q;
            const f32x4 acc = mma_tile(VnT + 16 * ct * LW, LW, Wm + 16 * it * LW, LW, 4, (f32x4){0.f, 0.f, 0.f, 0.f}, r, g);
            const int i = 16 * it + r, c = 16 * ct + 4 * g; const float bias = bs[i];
            const u32x2 up = upv[q][it];
            u32x2 w; w.x = pk2(bflo(up.x) * (acc[0] + bias), bfhi(up.x) * (acc[1] + bias)); w.y = pk2(bflo(up.y) * (acc[2] + bias), bfhi(up.y) * (acc[3] + bias));
            *(u32x2*)(MIX0 + (tok0 + i) * DM + 1024 + 256 * grp + c) = w; }
    __syncthreads();
}

template <bool HG>
__device__ __forceinline__ void postnorm_rows(const Args& a, int gw, int NGW, int lane) {
    asm volatile("" : "+v"(lane));
    const bf16* RAW = (const bf16*)(a.ws + WS_RAW); const bf16* Z = (const bf16*)(a.ws + WS_Z);
    bf16* O = (bf16*)(a.ws + (HG ? WS_MIX1 : WS_MIX0)); const int ldo = DM, ldz = HG ? ODD_PAD : EVEN_IN;
    f32x4 ng[4];
    if (HG) {
#pragma unroll
        for (int e = 0; e < 4; ++e) ng[e] = *(const f32x4*)(a.in[I_HG_NG] + 16 * lane + 4 * e); }
    for (int m0 = gw; m0 < M; m0 += 2 * NGW) {
        u32x4 p0[2], p1[2], g0[2], g1[2];
#pragma unroll
        for (int q = 0; q < 2; ++q) { const int m = (m0 + q * NGW < M) ? m0 + q * NGW : m0;
            const bf16* rr = RAW + (size_t)m * 1024 + 16 * lane; const bf16* gr = Z + (size_t)m * ldz + 3072 + 16 * lane;
            p0[q] = *(const u32x4*)rr; p1[q] = *(const u32x4*)(rr + 8); g0[q] = *(const u32x4*)gr; g1[q] = *(const u32x4*)(gr + 8); }
#pragma unroll
        for (int q = 0; q < 2; ++q) { const int m = m0 + q * NGW; if (m >= M) break;
            float x[16], gt[16];
#pragma unroll
            for (int e = 0; e < 4; ++e) { x[2 * e] = bflo(p0[q][e]); x[2 * e + 1] = bfhi(p0[q][e]); x[8 + 2 * e] = bflo(p1[q][e]); x[8 + 2 * e + 1] = bfhi(p1[q][e]);
                gt[2 * e] = bflo(g0[q][e]); gt[2 * e + 1] = bfhi(g0[q][e]); gt[8 + 2 * e] = bflo(g1[q][e]); gt[8 + 2 * e + 1] = bfhi(g1[q][e]); }
            float s = 0.f;
#pragma unroll
            for (int e = 0; e < 16; ++e) s += x[e] * x[e];
            s = HG ? row_sum8(s) : row_sum16(s);
            const float rstd = __builtin_amdgcn_rsqf(s * (HG ? (1.0f / 128.0f) : (1.0f / 256.0f)) + EPS);
            float y[16];
#pragma unroll
            for (int e = 0; e < 16; ++e) { float v = x[e] * rstd; if (HG) v *= ng[e >> 2][e & 3]; y[e] = v * (gt[e] * __builtin_amdgcn_rcpf(1.0f + __expf(-gt[e]))); }
            u32x4 o0, o1; o0.x = pk2(y[0], y[1]); o0.y = pk2(y[2], y[3]); o0.z = pk2(y[4], y[5]); o0.w = pk2(y[6], y[7]); o1.x = pk2(y[8], y[9]); o1.y = pk2(y[10], y[11]); o1.z = pk2(y[12], y[13]); o1.w = pk2(y[14], y[15]);
            bf16* op = O + (size_t)m * ldo + 16 * lane; *(u32x4*)op = o0; *(u32x4*)(op + 8) = o1; }
    }
}
__device__ __forceinline__ void kvn_rows(const Args& a, int gw, int NGW, int lane) {
    asm volatile("" : "+v"(lane));
    const bf16* Z = (const bf16*)(a.ws + WS_Z); bf16* KVN = (bf16*)(a.ws + WS_KVN);
    for (int m = gw; m < M; m += NGW) {
        const u32x2 p = *(const u32x2*)(Z + (size_t)m * ODD_PAD + Z1_CKV + 4 * lane);
        const float x0 = bflo(p.x), x1 = bfhi(p.x), x2 = bflo(p.y), x3 = bfhi(p.y);
        const float rstd = __builtin_amdgcn_rsqf(wave_sum(x0 * x0 + x1 * x1 + x2 * x2 + x3 * x3) * (1.0f / 256.0f) + EPS);
        const f32x4 gg = *(const f32x4*)(a.in[I_CKV_G] + 4 * lane);
        u32x2 w; w.x = pk2(x0 * rstd * gg.x, x1 * rstd * gg.y); w.y = pk2(x2 * rstd * gg.z, x3 * rstd * gg.w);
        *(u32x2*)(KVN + (size_t)m * 256 + 4 * lane) = w;
        { const bf16* cr = Z + (size_t)m * ODD_PAD + Z1_CQ; float s = 0.f;
#pragma unroll
          for (int e = 0; e < 6; ++e) { const float x = bf2f(cr[lane + 64 * e]); s += x * x; }
          s = wave_sum(s) * (1.0f / 384.0f); if (lane == 0) ((float*)(a.ws + WS_MSCQ))[m] = s; }
    }
}

__device__ __forceinline__ unsigned f2key(float f) { const unsigned u = __float_as_uint(f); return u ^ ((u >> 31) ? 0xffffffffu : 0x80000000u); }


__device__ __forceinline__ int wave_sum_i(int v) {
    v += __builtin_amdgcn_update_dpp(0, v, 0xB1, 0xF, 0xF, true); v += __builtin_amdgcn_update_dpp(0, v, 0x4E, 0xF, 0xF, true);
    v += __builtin_amdgcn_update_dpp(0, v, 0x141, 0xF, 0xF, true); v += __builtin_amdgcn_update_dpp(0, v, 0x140, 0xF, 0xF, true);
    return (__builtin_amdgcn_readlane(v, 0) + __builtin_amdgcn_readlane(v, 16)) + (__builtin_amdgcn_readlane(v, 32) + __builtin_amdgcn_readlane(v, 48));
}
__device__ __forceinline__ void transpose32(unsigned (&A)[32]) {
    unsigned m = 0x0000FFFFu;
#pragma unroll
    for (int j = 16; j != 0; j >>= 1) {
#pragma unroll
        for (int k0 = 0; k0 < 32; ++k0) { if (k0 & j) continue; const unsigned t = (A[k0] ^ (A[k0 + j] >> j)) & m; A[k0] ^= t; A[k0 + j] ^= (t << j); }
        m ^= (m << (j >> 1));
    }
}
template <int NB>
__device__ __forceinline__ void select_top256(const LAS float* sq, int nk, unsigned short* so, int lane) {
    unsigned P[NB][32], C[NB], G[NB];
    const int nreg = nk >> 6;
#pragma unroll
    for (int b = 0; b < NB; ++b) {
#pragma unroll
        for (int k = 0; k < 32; ++k) { const int i = 32 * b + k; P[b][k] = (i < nreg) ? f2key(sq[64 * i + lane]) : 0u; }
        const int nv = nreg - 32 * b; C[b] = (nv <= 0) ? 0u : (nv >= 32 ? 0xFFFFFFFFu : (0xFFFFFFFFu << (32 - nv))); G[b] = 0u;
        transpose32(P[b]);
    }
    bool done = false;
#pragma unroll
    for (int p = 0; p < 32; ++p) {
        if (!done) {
            int c = 0; unsigned x[NB];
#pragma unroll
            for (int b = 0; b < NB; ++b) { x[b] = C[b] & P[b][p]; c += __popc(G[b] | x[b]); }
            const int cnt = wave_sum_i(c);
            if (cnt >= 256) {
#pragma unroll
                for (int b = 0; b < NB; ++b) C[b] = x[b];
                if (cnt == 256) { done = true;
#pragma unroll
                    for (int b = 0; b < NB; ++b) { G[b] |= C[b]; C[b] = 0u; } }
            } else {
#pragma unroll
                for (int b = 0; b < NB; ++b) { G[b] |= x[b]; C[b] &= ~P[b][p]; }
            }
        }
    }
    if (!done) {
        int cg = 0, cc = 0;
#pragma unroll
        for (int b = 0; b < NB; ++b) { cg += __popc(G[b]); cc += __popc(C[b]); }
        int need = 256 - wave_sum_i(cg); const int nc = wave_sum_i(cc);
        if (nc == need) {
#pragma unroll
            for (int b = 0; b < NB; ++b) G[b] |= C[b];
        } else {
            const unsigned long long lt_mask = (lane == 0) ? 0ull : (~0ull >> (64 - lane));
            for (int i = 0; i < nreg && need > 0; ++i) { const unsigned cb = (NB > 1 && i >= 32) ? C[NB - 1] : C[0]; const unsigned bit = 1u << (31 - (i & 31));
                const bool eq = (cb & bit) != 0u; const unsigned long long meq = __ballot(eq);
                if (eq && __popcll(meq & lt_mask) < need) { if (NB > 1 && i >= 32) G[NB - 1] |= bit; else G[0] |= bit; }
                need -= __popcll(meq); }
        }
    }
    int n = 0;
#pragma unroll
    for (int b = 0; b < NB; ++b) n += __popc(G[b]);
    int inc = n;
#pragma unroll
    for (int d = 1; d < 64; d <<= 1) { const int t = __shfl_up(inc, d); if (lane >= d) inc += t; }
    int pos = inc - n;
#pragma unroll
    for (int b = 0; b < NB; ++b) { unsigned m = G[b];
        while (m) { const int beta = __builtin_ctz(m); const int k = 31 - beta; if (pos < 256) so[pos] = (unsigned short)(64 * (32 * b + k) + lane); ++pos; m &= m - 1u; } }
}

__device__ __forceinline__ void idx_group(const Args& a, LAS unsigned char* lds, int grp, int tid, int lane, int wave) {
    LAS float* sc = (LAS float*)lds;
    const bf16* Z = (const bf16*)(a.ws + WS_Z); const bf16* QI = (const bf16*)(a.ws + WS_QI);
    unsigned short* SEL = (unsigned short*)(a.ws + WS_SEL); int* NSEL = (int*)(a.ws + WS_NSEL);
    const int m0 = grp * 8, b = m0 >> 12, t0 = m0 & 4095, cq = t0 >> 6, nk = 64 * (cq + 1);
    const size_t kb0 = (size_t)b * SEQ;
    if (nk <= 256) {
        for (int u = tid; u < 8 * 256; u += 512) { const int q = u >> 8, s = u & 255; SEL[(size_t)(m0 + q) * 256 + s] = (unsigned short)(s < nk ? s : 0); }
        if (tid < 8) NSEL[m0 + tid] = nk;
        return;
    }
    const int r = lane & 31, hh = lane >> 5;
    const int qsel = (r >> 2) & 1, head = (r & 3) + 4 * (r >> 3);
    bf16x8 af[4][4]; float wv[4][16];
#pragma unroll
    for (int p = 0; p < 4; ++p) { const bf16* qrow = QI + (size_t)(m0 + 2 * p + qsel) * 1024 + head * 64 + 8 * hh;
#pragma unroll
        for (int s = 0; s < 4; ++s) af[p][s] = *(const bf16x8*)(qrow + 16 * s);
        const bf16* wrow = Z + (size_t)(m0 + 2 * p + hh) * ODD_PAD + Z1_WIDX;
        const u32x4 w0 = *(const u32x4*)wrow, w1 = *(const u32x4*)(wrow + 8);
#pragma unroll
        for (int e = 0; e < 4; ++e) { wv[p][2 * e] = bflo(w0[e]); wv[p][2 * e + 1] = bfhi(w0[e]); wv[p][8 + 2 * e] = bflo(w1[e]); wv[p][8 + 2 * e + 1] = bfhi(w1[e]); } }
    const int nkt = nk >> 5;
    bf16x8 bnx[4];
    { const bf16* krow = Z + (kb0 + 32 * wave + r) * ODD_PAD + Z1_KIDX + 8 * hh;
#pragma unroll
      for (int s = 0; s < 4; ++s) bnx[s] = *(const bf16x8*)(krow + 16 * s); }
    for (int kt = wave; kt < nkt; kt += 8) {
        bf16x8 bfr[4];
#pragma unroll
        for (int s = 0; s < 4; ++s) bfr[s] = bnx[s];
        { const int ktn = (kt + 8 < nkt) ? kt + 8 : kt; const bf16* krow = Z + (kb0 + 32 * ktn + r) * ODD_PAD + Z1_KIDX + 8 * hh;
#pragma unroll
          for (int s = 0; s < 4; ++s) bnx[s] = *(const bf16x8*)(krow + 16 * s); }
        __builtin_amdgcn_sched_barrier(0);
#pragma unroll
        for (int p = 0; p < 4; ++p) {
            f32x16 acc;
#pragma unroll
            for (int e = 0; e < 16; ++e) acc[e] = 0.f;
#pragma unroll
            for (int s = 0; s < 4; ++s) acc = __builtin_amdgcn_mfma_f32_32x32x16_bf16(af[p][s], bfr[s], acc, 0, 0, 0);
            float v = 0.f;
#pragma unroll
            for (int e = 0; e < 16; ++e) v += wv[p][e] * fmaxf(acc[e], 0.f);
            sc[(2 * p + hh) * 4096 + 32 * kt + r] = v;
        }
    }
    __syncthreads();
    { unsigned short* so = SEL + (size_t)(m0 + wave) * 256; const LAS float* sq = sc + wave * 4096;
      if (nk <= 2048) select_top256<1>(sq, nk, so, lane); else select_top256<2>(sq, nk, so, lane);
      if (lane == 0) NSEL[m0 + wave] = 256; }
    __syncthreads();
}

__device__ __forceinline__ int rel_bucket(int rel) {
    const int ret = rel > 0 ? 16 : 0; const int n = rel < 0 ? -rel : rel;
    if (n < 8) return ret + n;
    int large = 8 + (int)(logf((float)n / 8.0f) / 3.4657359027997265f * 8.0f);
    large = large < 15 ? large : 15;
    return ret + large;
}
__device__ __forceinline__ unsigned kv_fx(unsigned row) { return ((row & 3u) << 2) | ((row >> 2) & 3u); }
__device__ __forceinline__ unsigned kv_off(unsigned row, unsigned ch) { return 512u * row + 16u * (ch ^ kv_fx(row)); }
typedef short s16x4 __attribute__((ext_vector_type(4)));
__device__ __forceinline__ void attn_queries(const Args& a, LAS unsigned char* lds, int q_begin, int q_end, int tid, int lane, int wave) {
    asm volatile("" : "+v"(lane)); asm volatile("" : "+v"(tid));
    constexpr int WREG = 19840, O_PW = 16384, O_ZW = 16384 + 640, O_SW = 16384 + 640 + 64, O_QW = 16384 + 640 + 64 + 512, LQW = 136, LP = 40, O_BIAS = 8 * WREG;
    static_assert(O_BIAS + 1024 <= LDS_BYTES - 128, "attention LDS map");
    LAS unsigned char* KVc = lds + wave * WREG; LAS bf16* Pw = (LAS bf16*)(KVc + O_PW); LAS float* Zw = (LAS float*)(KVc + O_ZW); LAS unsigned short* SELw = (LAS unsigned short*)(KVc + O_SW); LAS bf16* Qw = (LAS bf16*)(KVc + O_QW); LAS float* BIAS = (LAS float*)(lds + O_BIAS);
    const bf16* QRAW = (const bf16*)(a.ws + WS_QRAW); const bf16* KVN = (const bf16*)(a.ws + WS_KVN);
    const unsigned short* SEL = (const unsigned short*)(a.ws + WS_SEL); const int* NSEL = (const int*)(a.ws + WS_NSEL); const float* MSCQ = (const float*)(a.ws + WS_MSCQ);
    bf16* OBUF = (bf16*)(a.ws + WS_OBUF);
    const int r = lane & 15, g = lane >> 4, part = lane & 31, sub = lane >> 5, hq = r & 7;
    const unsigned q4 = (unsigned)(lane & 15) >> 2, p4 = (unsigned)lane & 3u;
    if (tid < 256) BIAS[tid] = a.in[I_RELB][tid];
    __syncthreads();
    for (int m = q_begin + wave; m < q_end; m += 8) {
        const int t = m & 4095; const size_t kb0 = (size_t)(m >> 12) * SEQ;
        const int nch = __builtin_amdgcn_readfirstlane(NSEL[m]) >> 5;
        const unsigned short* selm = SEL + (size_t)m * 256;
        { const u32x2 sv = *(const u32x2*)((const char*)SEL + ((unsigned)m * 512u + 8u * (unsigned)lane)); *(LAS u32x2*)(SELw + 4 * lane) = sv; }
        asm volatile("" ::: "memory");
        bf16x8 qf[8];
        { u32x4 raw[8]; float ss = 0.f;
#pragma unroll
          for (int s = 0; s < 8; ++s) { raw[s] = *(const u32x4*)((const char*)QRAW + ((unsigned)m * 4096u + (unsigned)(512 * hq + 64 * s + 16 * g)));
#pragma unroll
              for (int e = 0; e < 4; ++e) { const float x0 = bflo(raw[s][e]), x1 = bfhi(raw[s][e]); ss += x0 * x0 + x1 * x1; } }
          ss += __shfl_xor(ss, 16); ss += __shfl_xor(ss, 32);
          const float rstd = __builtin_amdgcn_rsqf(ss * (1.0f / 256.0f) + EPS * (MSCQ[m] + EPS));
#pragma unroll
          for (int s = 0; s < 8; ++s) { const f32x4 g0 = *(const f32x4*)(a.in[I_QN_G] + 32 * s + 8 * g), g1 = *(const f32x4*)(a.in[I_QN_G] + 32 * s + 8 * g + 4);
              u32x4 w; w.x = pk2(bflo(raw[s].x) * rstd * g0.x, bfhi(raw[s].x) * rstd * g0.y); w.y = pk2(bflo(raw[s].y) * rstd * g0.z, bfhi(raw[s].y) * rstd * g0.w);
              w.z = pk2(bflo(raw[s].z) * rstd * g1.x, bfhi(raw[s].z) * rstd * g1.y); w.w = pk2(bflo(raw[s].w) * rstd * g1.z, bfhi(raw[s].w) * rstd * g1.w);
              qf[s] = __builtin_bit_cast(bf16x8, w); } }
        if (r < 8) {
#pragma unroll
            for (int s = 4; s < 8; ++s) *(LAS bf16x8*)(Qw + hq * LQW + 32 * (s - 4) + 8 * g) = qf[s]; }
        asm volatile("" ::: "memory");
        u32x4 pre[16];
        { u32x4 iw[4];
#pragma unroll
          for (int k = 0; k < 4; ++k) iw[k] = *(const LAS u32x4*)(SELw + 8 * k);
#pragma unroll
          for (int i = 0; i < 16; ++i) { const unsigned idx = (iw[i >> 2][i & 3] >> (16 * sub)) & 0xffffu; pre[i] = *(const u32x4*)((const char*)KVN + (((unsigned)kb0 + idx) * 512u + 16u * (unsigned)part)); } }
        f32x4 o[16]; f32x4 zs = (f32x4){0.f, 0.f, 0.f, 0.f};
#pragma unroll
        for (int c2 = 0; c2 < 16; ++c2) o[c2] = (f32x4){0.f, 0.f, 0.f, 0.f};
        const unsigned fxr = kv_fx((unsigned)r);
        for (int c = 0; c < nch; ++c) {
#pragma unroll
            for (int i = 0; i < 16; ++i) *(LAS u32x4*)(KVc + kv_off((unsigned)(2 * i + sub), (unsigned)part)) = pre[i];
            const int kp0 = (int)SELw[32 * c + r], kp1 = (int)SELw[32 * c + 16 + r];
            asm volatile("" ::: "memory");
            if (c + 1 < nch) { u32x4 iw[4];
#pragma unroll
                for (int k = 0; k < 4; ++k) iw[k] = *(const LAS u32x4*)(SELw + 32 * (c + 1) + 8 * k);
#pragma unroll
                for (int i = 0; i < 16; ++i) { const unsigned idx = (iw[i >> 2][i & 3] >> (16 * sub)) & 0xffffu; pre[i] = *(const u32x4*)((const char*)KVN + (((unsigned)kb0 + idx) * 512u + 16u * (unsigned)part)); } }
            f32x4 acc0 = (f32x4){0.f, 0.f, 0.f, 0.f}, acc1 = (f32x4){0.f, 0.f, 0.f, 0.f};
            { const LAS unsigned char* rowp0 = KVc + 512 * r; const LAS unsigned char* rowp1 = rowp0 + 512 * 16;
#pragma unroll
              for (int s = 0; s < 8; ++s) { const unsigned so = 16u * ((unsigned)(4 * s + g) ^ fxr);
                  const bf16x8 k0 = *(const LAS bf16x8*)(rowp0 + so), k1 = *(const LAS bf16x8*)(rowp1 + so);
                  const bf16x8 qs = (s < 4) ? qf[s] : *(const LAS bf16x8*)(Qw + hq * LQW + 32 * (s - 4) + 8 * g);
                  acc0 = __builtin_amdgcn_mfma_f32_16x16x32_bf16(qs, k0, acc0, 0, 0, 0); acc1 = __builtin_amdgcn_mfma_f32_16x16x32_bf16(qs, k1, acc1, 0, 0, 0); } }
            { const int gg = g & 1; const int b0 = rel_bucket(kp0 - t), b1 = rel_bucket(kp1 - t);
              const f32x4 bb0 = *(const LAS f32x4*)(BIAS + b0 * 8 + 4 * gg), bb1 = *(const LAS f32x4*)(BIAS + b1 * 8 + 4 * gg);
              f32x4 p0, p1;
#pragma unroll
              for (int jj = 0; jj < 4; ++jj) { p0[jj] = __expf(acc0[jj] * 0.0625f + bb0[jj] - 8.0f); p1[jj] = __expf(acc1[jj] * 0.0625f + bb1[jj] - 8.0f); }
              zs += p0 + p1;
              if (g < 2) {
#pragma unroll
                  for (int jj = 0; jj < 4; ++jj) { Pw[(4 * g + jj) * LP + r] = f2bf1(p0[jj]); Pw[(4 * g + jj) * LP + 16 + r] = f2bf1(p1[jj]); } } }
            asm volatile("" ::: "memory");
            { const bf16x8 pf = *(const LAS bf16x8*)(Pw + hq * LP + 8 * g);
              LAS unsigned char* kvp = KVc; asm volatile("" : "+v"(kvp));
              const unsigned row0 = 8u * g + q4, row1 = row0 + 4u;
#pragma unroll
              for (int c2 = 0; c2 < 16; ++c2) { const unsigned ch = 2u * c2 + (p4 >> 1);
                  const s16x4 a0 = __builtin_amdgcn_ds_read_tr16_b64_v4i16((LAS s16x4*)(kvp + kv_off(row0, ch) + 8u * (p4 & 1u)));
                  const s16x4 a1 = __builtin_amdgcn_ds_read_tr16_b64_v4i16((LAS s16x4*)(kvp + kv_off(row1, ch) + 8u * (p4 & 1u)));
                  const bf16x8 af = {a0[0], a0[1], a0[2], a0[3], a1[0], a1[1], a1[2], a1[3]};
                  o[c2] = __builtin_amdgcn_mfma_f32_16x16x32_bf16(af, pf, o[c2], 0, 0, 0); } }
            asm volatile("" ::: "memory");
        }
        { const float z0 = row_sum16(zs[0]), z1 = row_sum16(zs[1]), z2 = row_sum16(zs[2]), z3 = row_sum16(zs[3]);
          if (g < 2 && r == 0) { Zw[4 * g] = z0; Zw[4 * g + 1] = z1; Zw[4 * g + 2] = z2; Zw[4 * g + 3] = z3; }
          asm volatile("" ::: "memory");
          const float iz = 1.0f / Zw[hq];
          if (r < 8) { const unsigned oo = (unsigned)m * 4096u + (unsigned)(512 * r + 8 * g);
#pragma unroll
              for (int c2 = 0; c2 < 16; ++c2) { u32x2 w; w.x = pk2(o[c2][0] * iz, o[c2][1] * iz); w.y = pk2(o[c2][2] * iz, o[c2][3] * iz); *(u32x2*)((char*)OBUF + (oo + 32u * c2)) = w; } }
          asm volatile("" ::: "memory"); }
    }
    __syncthreads();
}

__device__ __forceinline__ void uv_project(const Args& a, int u_begin, int u_end, int u_step, int lane) {
    asm volatile("" : "+v"(lane));
    const bf16* OBUF = (const bf16*)(a.ws + WS_OBUF); const bf16* WUVT = (const bf16*)(a.ws + WS_WUVT); bf16* MIX1 = (bf16*)(a.ws + WS_MIX1);
    const int r = lane & 15, g = lane >> 4;
    for (int u = u_begin; u < u_end; u += u_step) { const int h = u & 7, mt = u >> 3;
        bf16x8 of[8];
#pragma unroll
        for (int s = 0; s < 8; ++s) of[s] = *(const bf16x8*)(OBUF + (size_t)(16 * mt + r) * 2048 + 256 * h + 32 * s + 8 * g);
#pragma unroll
        for (int np = 0; np < 4; ++np) { bf16x8 wf[2][8];
#pragma unroll
            for (int q = 0; q < 2; ++q) { const bf16* wr = WUVT + ((size_t)h * 128 + 16 * (2 * np + q) + r) * 256 + 8 * g;
#pragma unroll
                for (int s = 0; s < 8; ++s) wf[q][s] = *(const bf16x8*)(wr + 32 * s); }
            __builtin_amdgcn_sched_barrier(0);
#pragma unroll
            for (int q = 0; q < 2; ++q) { f32x4 acc = (f32x4){0.f, 0.f, 0.f, 0.f};
#pragma unroll
                for (int s = 0; s < 8; ++s) acc = __builtin_amdgcn_mfma_f32_16x16x32_bf16(wf[q][s], of[s], acc, 0, 0, 0);
                u32x2 w; w.x = pk2(acc[0], acc[1]); w.y = pk2(acc[2], acc[3]);
                *(u32x2*)(MIX1 + (size_t)(16 * mt + r) * DM + 1024 + 128 * h + 16 * (2 * np + q) + 4 * g) = w; }
            __builtin_amdgcn_sched_barrier(0); }
    }
}

#ifndef MK_SINGLE
#define MK_SINGLE 1
#endif
#ifndef PG8_SP2
#define PG8_SP2 true
#endif
#ifndef PG8_ALIGN
#define PG8_ALIGN true
#endif

__global__ void __launch_bounds__(512, 2) mk_fwd(Args a) {
    __builtin_assume(__builtin_amdgcn_workitem_id_y() == 0); __builtin_assume(__builtin_amdgcn_workitem_id_z() == 0);
    extern __shared__ __attribute__((aligned(16))) unsigned char lds_raw[];
    LAS unsigned char* lds = (LAS unsigned char*)lds_raw;
    cg::grid_group grid = cg::this_grid();
    const int tid = threadIdx.x, lane = tid & 63, wave = __builtin_amdgcn_readfirstlane(tid >> 6);
    const int G = gridDim.x, bx = blockIdx.x;
    const int gw = bx * 8 + wave, NGW = G * 8;
    unsigned char* ws = a.ws;
    const int lo = a.ph_lo, hi = a.ph_hi;
#define IN(k) (lo <= (k) && (k) < hi)
    volatile LAS unsigned* xst = (volatile LAS unsigned*)(lds + LDS_BYTES - 64);
    if (tid < 16) xst[tid] = 0u;
    __syncthreads();
    const bool fused = (hi - lo) > 1;
    XcdBarrier xbar; xbar.bar = (unsigned*)(a.ws + WS_BAR); xbar.x = 0; xbar.st = xst;
    if (fused) xbar = xcd_barrier_post((unsigned*)(a.ws + WS_BAR), xst);
#define SEAM(k) do { if (IN(k) && IN((k) + 1)) xcd_barrier(xbar); } while (0)
    if (lo < 0) grid.sync();
#ifndef PROBE_REP_MASK
#define PROBE_REP_MASK 0
#endif
#define REP(k) for (int rep_ = 0; rep_ <= ((PROBE_REP_MASK >> (k)) & 1); ++rep_)
#define RSYNC() do { if (rep_) grid.sync(); } while (0)
    bf16* XN = (bf16*)(ws + WS_XN); bf16* Zb = (bf16*)(ws + WS_Z); float* X1 = (float*)(ws + WS_X1); float* SSQ = (float*)(ws + WS_SSQ);

    if (IN(0)) { p0_prologue(a, lds, tid, lane, wave, G); }
    SEAM(0);
    if (IN(1)) { pg8::Gemm g{XN, (const bf16*)(ws + WS_WIN0), M, EVEN_IN, DM, DM, DM}; pg8::StaticOrder S; S.init(M, EVEN_IN, G, bx);
        pg8::EpiBf16 E{Zb, EVEN_IN, Zb, EVEN_IN, 1 << 30, 16, nullptr};
        pg8::gemm_phase<pg8::EpiBf16, PG8_ALIGN, PG8_SP2>(lds, g, S, E); }
    SEAM(1);
    if (IN(2)) {
        for (int it = bx; it < 512; it += G) prep_item<256, false>(a, lds, it, tid, lane, wave);
    }
    SEAM(2);
    if (IN(3)) {
        if (bx < 64) { if (!(a.flags & 1)) scan_item<256, false>(a, lds, bx, tid, lane, wave); }
        else { if (!(a.flags & 2)) { conv_set<1>(a, lds, tid, lane, wave, (bx - 64) * 8 + wave, (G - 64) * 8, (bx - 64) * 512 + tid, (G - 64) * 512);
                conv_set<3>(a, lds, tid, lane, wave, (bx - 64) * 8 + wave, (G - 64) * 8, (bx - 64) * 512 + tid, (G - 64) * 512); }
            __syncthreads();
            for (int it = bx - 64; it < 256; it += G - 64) sgu_item(a, lds, it, tid, lane, wave); }
    }
    SEAM(3);
    if (IN(4)) postnorm_rows<false>(a, gw, NGW, lane);
    SEAM(4);
    if (IN(5)) { pg8::Gemm g{(const bf16*)(ws + WS_MIX0), (const bf16*)(ws + WS_WOUT0), M, DM, DM, DM, DM}; pg8::StaticOrder S; S.init(M, DM, G, bx);
        pg8::EpiRes E{a.in[I_X], X1, DM, XN, SSQ};
        pg8::gemm_phase<pg8::EpiRes, PG8_ALIGN, PG8_SP2>(lds, g, S, E); }
    SEAM(5);
    if (IN(6)) { pg8::Gemm g{XN, (const bf16*)(ws + WS_WGU0), M, 2 * FF, DM, DM, DM}; pg8::StaticOrder S; S.init(M, 2 * FF, G, bx);
        pg8::EpiSwiglu E{Zb, FF, SSQ};
        pg8::gemm_phase<pg8::EpiSwiglu, PG8_ALIGN, PG8_SP2>(lds, g, S, E); }
    SEAM(6);
    if (IN(7)) { pg8::Gemm g{Zb, (const bf16*)(ws + WS_WD0), M, DM, FF, FF, FF}; pg8::StaticOrder S; S.init(M, DM, G, bx);
        pg8::EpiRes E{X1, a.out, DM, XN, SSQ + M};
        pg8::gemm_phase<pg8::EpiRes, PG8_ALIGN, PG8_SP2>(lds, g, S, E); }
    SEAM(7);
    if (IN(8)) { pg8::Gemm g{XN, (const bf16*)(ws + WS_WIN1), M, ODD_PAD, DM, DM, DM}; pg8::StaticOrder S; S.init(M, ODD_PAD, G, bx);
        pg8::EpiBf16 E{Zb, ODD_PAD, Zb, ODD_PAD, 1 << 30, 1 << 30, SSQ + M};
        pg8::gemm_phase<pg8::EpiBf16, PG8_ALIGN, PG8_SP2>(lds, g, S, E); }
    SEAM(8);
    if (IN(9)) {
        for (int it = bx; it < 1024; it += G) prep_item<128, true>(a, lds, it, tid, lane, wave);
        kvn_rows(a, gw, NGW, lane);
        asm volatile("s_waitcnt vmcnt(0)" ::: "memory"); __syncthreads();
        pg8::Gemm g{Zb + Z1_CQ, (const bf16*)(ws + WS_WDSA), M, 3072, 384, ODD_PAD, 384}; pg8::StaticOrder S; S.init(M, 3072, G, bx);
        pg8::EpiBf16 E{(bf16*)(ws + WS_QRAW), 2048, (bf16*)(ws + WS_QI), 1024, 8, 1 << 30, nullptr};
        pg8::gemm_phase<pg8::EpiBf16, PG8_ALIGN, PG8_SP2>(lds, g, S, E);
    }
    SEAM(9);
    if (IN(10)) {
        if (bx < 64) { if (!(a.flags & 1)) scan_item<128, true>(a, lds, bx, tid, lane, wave); }
        else { if (!(a.flags & 2)) conv_set<2>(a, lds, tid, lane, wave, (bx - 64) * 8 + wave, (G - 64) * 8, (bx - 64) * 512 + tid, (G - 64) * 512); }
        { unsigned* qc = (unsigned*)(ws + WS_QCNT) + ((a.flags & 64) ? 16 : 0); LAS int* sh = (LAS int*)(lds + LDS_BYTES - 96);
          __syncthreads();
          for (;;) {
              if (tid == 0) sh[0] = (int)__hip_atomic_fetch_add(qc, 1u, __ATOMIC_RELAXED, __HIP_MEMORY_SCOPE_AGENT);
              __syncthreads();
              const int j = sh[0];
              __syncthreads();
              if (j >= 1024) break;
              const int c = 63 - (j >> 4), w16 = j & 15; const int grp = (w16 >> 3) * 512 + c * 8 + (w16 & 7);
              idx_group(a, lds, grp, tid, lane, wave); } }
    }
    SEAM(10);
    if (IN(12)) {
        postnorm_rows<true>(a, gw, NGW, lane);
        { int qb, qe;
          if (G == 256) { const int x = bx & 7, j = bx >> 3; qb = (x & 1) * SEQ + 32 * ((x >> 1) * 32 + j); qe = qb + 32; }
          else { const int per = (M + G - 1) / G; qb = bx * per; qe = (qb + per < M) ? qb + per : M; }
          attn_queries(a, lds, qb, qe, tid, lane, wave);
          if (G == 256) { asm volatile("s_waitcnt vmcnt(0)" ::: "memory"); __syncthreads(); uv_project(a, (qb >> 4) * 8 + wave, (qb >> 4) * 8 + 16, 8, lane); } }
    }
    SEAM(12);
    if (IN(13)) { if (G != 256) uv_project(a, gw, (M / 16) * 8, NGW, lane); }
    if (G != 256) SEAM(13);
    if (IN(14)) { pg8::Gemm g{(const bf16*)(ws + WS_MIX1), (const bf16*)(ws + WS_WOUT1), M, DM, DM, DM, DM}; pg8::StaticOrder S; S.init(M, DM, G, bx);
        pg8::EpiRes E{a.out, X1, DM, XN, SSQ + 2 * M};
        pg8::gemm_phase<pg8::EpiRes, PG8_ALIGN, PG8_SP2>(lds, g, S, E); }
    SEAM(14);
    if (IN(15)) { pg8::Gemm g{XN, (const bf16*)(ws + WS_WGU1), M, 2 * FF, DM, DM, DM}; pg8::StaticOrder S; S.init(M, 2 * FF, G, bx);
        pg8::EpiSwiglu E{Zb, FF, SSQ + 2 * M};
        pg8::gemm_phase<pg8::EpiSwiglu, PG8_ALIGN, PG8_SP2>(lds, g, S, E); }
    SEAM(15);
    if (IN(16)) { pg8::Gemm g{Zb, (const bf16*)(ws + WS_WD1), M, DM, FF, FF, FF}; pg8::StaticOrder S; S.init(M, DM, G, bx);
        pg8::EpiRes E{X1, a.out, DM, nullptr, nullptr};
        pg8::gemm_phase<pg8::EpiRes, PG8_ALIGN, PG8_SP2>(lds, g, S, E); }
#undef IN
#undef SEAM
}

extern "C" void kernel_launch(void* const* d_in, const int* in_sizes, int n_in, void* d_out, int out_size, void* d_ws, size_t ws_size, hipStream_t stream) {
    static int grid = 0;
    if (grid == 0) {
        if (n_in != 23 || out_size != M * DM || ws_size < WS_END) { fprintf(stderr, "kernel_launch: unexpected shapes (n_in %d out %d ws %zu, need %zu)\n", n_in, out_size, ws_size, (size_t)WS_END); grid = -1; return; }
        int dev = 0, cus = 0, per_cu = 0;
        if (hipGetDevice(&dev) != hipSuccess || hipDeviceGetAttribute(&cus, hipDeviceAttributeMultiprocessorCount, dev) != hipSuccess) { grid = -1; return; }
        if (hipFuncSetAttribute((const void*)mk_fwd, hipFuncAttributeMaxDynamicSharedMemorySize, LDS_BYTES) != hipSuccess) { fprintf(stderr, "kernel_launch: hipFuncSetAttribute failed\n"); grid = -1; return; }
        if (hipOccupancyMaxActiveBlocksPerMultiprocessor(&per_cu, (const void*)mk_fwd, 512, LDS_BYTES) != hipSuccess || per_cu < 1) { fprintf(stderr, "kernel_launch: occupancy query says %d blocks per CU\n", per_cu); (void)hipGetLastError(); grid = -1; return; }
        grid = cus;
        if (grid != 256) fprintf(stderr, "kernel_launch: note: %d CUs (work split assumes 256)\n", grid);
    }
    if (grid < 0) return;
    Args a{};
    for (int i = 0; i < 23; ++i) a.in[i] = (const float*)d_in[i];
    a.out = (float*)d_out; a.ws = (unsigned char*)d_ws;
    if (hipMemsetAsync((unsigned char*)d_ws + WS_BAR, 0, BAR_BYTES, stream) != hipSuccess) { fprintf(stderr, "kernel_launch: hipMemsetAsync failed\n"); return; }
#if MK_SINGLE
    a.ph_lo = 0; a.ph_hi = NPHASES;
    void* args[] = {&a};
    hipError_t e = hipLaunchCooperativeKernel((const void*)mk_fwd, dim3(grid), dim3(512), args, LDS_BYTES, stream);
    if (e != hipSuccess) fprintf(stderr, "kernel_launch: cooperative launch failed: %s\n", hipGetErrorString(e));
#else
#ifndef PROBE_HOST_MASK
#define PROBE_HOST_MASK 0
#endif
#ifndef PROBE_REP_FLAGS
#define PROBE_REP_FLAGS 0
#endif
#ifndef PROBE_REP_COUNT
#define PROBE_REP_COUNT 1
#endif
    for (int p = 0; p < NPHASES; ++p) for (int rep = 0; rep <= (((PROBE_HOST_MASK >> p) & 1) ? PROBE_REP_COUNT : 0); ++rep) { a.ph_lo = p; a.ph_hi = p + 1; a.flags = rep ? PROBE_REP_FLAGS : 0; void* args[] = {&a};
        hipError_t e = hipLaunchCooperativeKernel((const void*)mk_fwd, dim3(grid), dim3(512), args, LDS_BYTES, stream);
        if (e != hipSuccess) { fprintf(stderr, "kernel_launch: launch %d failed: %s\n", p, hipGetErrorString(e)); break; } }
#endif
}
```

```cpp
#include <hip/hip_runtime.h>
#include <hip/hip_cooperative_groups.h>
#include <cstdio>
#include <cstdint>
namespace cg = cooperative_groups;

#define LAS __attribute__((address_space(3)))
typedef unsigned short bf16;
typedef short bf16x8 __attribute__((ext_vector_type(8)));
typedef float f32x2 __attribute__((ext_vector_type(2)));
typedef float f32x4 __attribute__((ext_vector_type(4)));
typedef float f32x16 __attribute__((ext_vector_type(16)));
typedef unsigned u32x2 __attribute__((ext_vector_type(2)));
typedef unsigned u32x4 __attribute__((ext_vector_type(4)));

constexpr int BATCH = 2, SEQ = 4096, DM = 2048, M = BATCH * SEQ, FF = 5632;
constexpr int EVEN_IN = 6144, ODD_IN = 4816, ODD_PAD = 4864;
constexpr float EPS = 1e-6f;
constexpr int Z1_HQ = 0, Z1_HF = 1024, Z1_HI = 2048, Z1_HGATE = 3072, Z1_CQ = 4096, Z1_CKV = 4480, Z1_KIDX = 4736, Z1_WIDX = 4800;

__device__ __forceinline__ unsigned f2bf(float f) { unsigned u = __float_as_uint(f); return (u + 0x7fffu + ((u >> 16) & 1u)) >> 16; }
typedef __bf16 bf16x2_t __attribute__((ext_vector_type(2)));
__device__ __forceinline__ unsigned pk2(float lo, float hi) { const f32x2 v = {lo, hi}; const bf16x2_t b = __builtin_convertvector(v, bf16x2_t); return __builtin_bit_cast(unsigned, b); }
__device__ __forceinline__ bf16 f2bf1(float f) { return (bf16)(pk2(f, 0.f) & 0xffffu); }
__device__ __forceinline__ float bflo(unsigned w) { return __uint_as_float(w << 16); }
__device__ __forceinline__ float bfhi(unsigned w) { return __uint_as_float(w & 0xffff0000u); }
__device__ __forceinline__ float bf2f(bf16 b) { return __uint_as_float(((unsigned)b) << 16); }
template <int CTRL> __device__ __forceinline__ float dpp_f(float x) { return __builtin_bit_cast(float, __builtin_amdgcn_update_dpp(0, __builtin_bit_cast(int, x), CTRL, 0xF, 0xF, true)); }
__device__ __forceinline__ float row_sum8(float x) { x += dpp_f<0xB1>(x); x += dpp_f<0x4E>(x); x += dpp_f<0x141>(x); return x; }
__device__ __forceinline__ float row_sum16(float x) { x = row_sum8(x); x += dpp_f<0x140>(x); return x; }
__device__ __forceinline__ float row_max16(float x) { x = fmaxf(x, dpp_f<0xB1>(x)); x = fmaxf(x, dpp_f<0x4E>(x)); x = fmaxf(x, dpp_f<0x141>(x)); x = fmaxf(x, dpp_f<0x140>(x)); return x; }
__device__ __forceinline__ float rdlane(float x, int l) { return __builtin_bit_cast(float, __builtin_amdgcn_readlane(__builtin_bit_cast(int, x), l)); }
__device__ __forceinline__ float wave_sum(float v) { v = row_sum16(v); return (rdlane(v, 0) + rdlane(v, 16)) + (rdlane(v, 32) + rdlane(v, 48)); }
__device__ __forceinline__ float wave_max(float v) { v = row_max16(v); return fmaxf(fmaxf(rdlane(v, 0), rdlane(v, 16)), fmaxf(rdlane(v, 32), rdlane(v, 48))); }
__device__ __forceinline__ float sigmoidf_(float x) { return 1.0f / (1.0f + __expf(-x)); }
__device__ __forceinline__ float siluf_(float x) { return x / (1.0f + __expf(-x)); }
#define LDS_WAIT() asm volatile("s_waitcnt lgkmcnt(0)" ::: "memory")
#define LDS_BAR() do { asm volatile("s_waitcnt lgkmcnt(0)" ::: "memory"); __builtin_amdgcn_s_barrier(); asm volatile("" ::: "memory"); } while (0)

#ifndef PG8_WGM
#define PG8_WGM 2
#endif
namespace pg8 {
constexpr int BM = 256, BK = 64, HALF = 128, HTB = HALF * BK * 2  , STAGE_BYTES = 8 * HTB, NXCD = 8, WGM = PG8_WGM;

__host__ __device__ __forceinline__ int lds_byte(int r, int c) { const int st = (r >> 4) * 2 + (c >> 5), rr = r & 15, cc = c & 31, ob = rr * 64 + cc * 2; return st * 1024 + (ob ^ (((ob >> 9) & 1) << 5)); }
__host__ __device__ __forceinline__ void stage_rc(int b, int& R, int& C) { const int st = b / 1024, sb = b % 1024, swz = sb ^ (((sb >> 9) & 1) << 5); R = (st >> 1) * 16 + swz / 64; C = (st & 1) * 32 + (swz % 64) / 2; }
__host__ __device__ __forceinline__ int perm32(int rho) { const int n = rho >> 4, i = rho & 15; return 8 * (i >> 2) + 4 * n + (i & 3); }

struct Unit { int pm, pn, half; };
struct Gemm { const bf16* A; const bf16* Bt; int M, N, K, lda, ldb; };

struct StaticOrder {
    int nM, nN, nwg, G, c, wgm;
    __host__ __device__ void init(int M_, int N_, int G_, int c_, int wgm_ = WGM) { nM = M_ / BM; nN = N_ / BM; nwg = nM * nN; G = G_; c = c_; wgm = wgm_; }
    __host__ __device__ bool next(int i, Unit& u) const {
        if (c < 0) return false;
        const int base = i * G, rem = nwg - base; if (rem <= 0) return false;
        long L; u.half = -1;
        if (rem >= G || 2 * rem > G) { L = (long)base + c; if (L >= nwg) return false; }
        else { if (c >= 2 * rem) return false; L = (long)base + (c >> 1); u.half = c & 1; }
        int wgid = (int)L;
#ifndef PG8_NO_XCD_REMAP
        { const int q = nwg / NXCD, r = nwg % NXCD, xcd = wgid % NXCD, off = wgid / NXCD; wgid = (xcd < r ? xcd * (q + 1) : r * (q + 1) + (xcd - r) * q) + off; }
#endif
        const int nig = wgm * nN, gid = wgid / nig, fm = gid * wgm, gsz = (nM - fm) < wgm ? (nM - fm) : wgm;
        u.pm = fm + ((wgid % nig) % gsz); u.pn = (wgid % nig) / gsz; return true;
    }
};

__device__ __forceinline__ unsigned cvt_pk_bf16(float lo, float hi) { return pk2(lo, hi); }
__device__ __forceinline__ f32x2 gelu_pk(f32x2 v) {
    const f32x2 av = __builtin_elementwise_abs(v), d = av * 0.2316418882f + 1.0f;
    f32x2 t; t.x = __builtin_amdgcn_rcpf(d.x); t.y = __builtin_amdgcn_rcpf(d.y);
    f32x2 q = t * 0.5307027145f + (-0.7265760135f); q = q * t + 0.7107068705f; q = q * t + (-0.142248368f); q = q * t + 0.127414796f; q = q * t;
    const f32x2 s = (v * v) * (-0.72134752044f);
    f32x2 e; e.x = __builtin_amdgcn_exp2f(s.x); e.y = __builtin_amdgcn_exp2f(s.y);
    const f32x2 m = v * (q * e), r = v - m;
    f32x2 o; o.x = v.x < 0.f ? m.x : r.x; o.y = v.y < 0.f ? m.y : r.y; return o;
}

struct EpiBf16 {
    static constexpr bool PERM = true;
    bf16* O0; int ld0; bf16* O1; int ld1; int split_pn; int gelu_pn; const float* ssq;
    __device__ __forceinline__ f32x2 prefetch(const Unit& u, int wr, int lane) const { f32x2 p = {0.f, 0.f}; if (ssq) { p.x = ssq[u.pm * BM + wr * 64 + lane]; p.y = ssq[u.pm * BM + HALF + wr * 64 + lane]; } return p; }
    __device__ __forceinline__ void operator()(const f32x4 (&acc)[2][2][4][2], const Unit& u, int wr, int wc, int fr, int fq, f32x2 pre) const {
        const int row0 = u.pm * BM + wr * 64 + fr;
        bf16* base = O0; int ldc = ld0; int colt = u.pn * BM;
        if (u.pn >= split_pn) { base = O1; ldc = ld1; colt = (u.pn - split_pn) * BM; }
        const bool act = u.pn >= gelu_pn;
        const int col0 = colt + wc * 32 + 8 * fq;
#pragma unroll
        for (int ai = 0; ai < 2; ++ai) { if (u.half >= 0 && u.half != ai) continue;
#pragma unroll
            for (int m = 0; m < 4; ++m) { const int row = row0 + ai * HALF + m * 16; bf16* rowp = base + (size_t)row * ldc + col0;
                const float rs = ssq ? __builtin_amdgcn_rsqf(__shfl(ai ? pre.y : pre.x, 16 * m + fr) * (1.0f / 2048.0f) + 1e-6f) : 1.0f;
#pragma unroll
                for (int bj = 0; bj < 2; ++bj) { f32x4 v0 = acc[ai][bj][m][0] * rs, v1 = acc[ai][bj][m][1] * rs;
                    if (act) { f32x2 a = gelu_pk((f32x2){v0[0], v0[1]}), b = gelu_pk((f32x2){v0[2], v0[3]}), c = gelu_pk((f32x2){v1[0], v1[1]}), d = gelu_pk((f32x2){v1[2], v1[3]});
                        v0 = (f32x4){a.x, a.y, b.x, b.y}; v1 = (f32x4){c.x, c.y, d.x, d.y}; }
                    u32x4 w; w.x = cvt_pk_bf16(v0[0], v0[1]); w.y = cvt_pk_bf16(v0[2], v0[3]); w.z = cvt_pk_bf16(v1[0], v1[1]); w.w = cvt_pk_bf16(v1[2], v1[3]);
                    *(u32x4*)(rowp + bj * HALF) = w; } } }
    }
};
struct EpiRes {
    static constexpr bool PERM = true;
    const float* base; float* out; int ldc; bf16* xb; float* ssq;
    __device__ __forceinline__ f32x2 prefetch(const Unit&, int, int) const { return (f32x2){0.f, 0.f}; }
    __device__ __forceinline__ void operator()(const f32x4 (&acc)[2][2][4][2], const Unit& u, int wr, int wc, int fr, int fq, f32x2) const {
        const int row0 = u.pm * BM + wr * 64 + fr, col0 = u.pn * BM + wc * 32 + 8 * fq;
#pragma unroll
        for (int ai = 0; ai < 2; ++ai) { if (u.half >= 0 && u.half != ai) continue;
#pragma unroll
            for (int m = 0; m < 4; ++m) { const int row = row0 + ai * HALF + m * 16; const size_t off = (size_t)row * ldc + col0; float sq = 0.f;
#pragma unroll
                for (int bj = 0; bj < 2; ++bj) { const f32x4 b0 = *(const f32x4*)(base + off + bj * HALF), b1 = *(const f32x4*)(base + off + bj * HALF + 4);
                    const f32x4 v0 = b0 + acc[ai][bj][m][0], v1 = b1 + acc[ai][bj][m][1];
                    *(f32x4*)(out + off + bj * HALF) = v0; *(f32x4*)(out + off + bj * HALF + 4) = v1;
                    if (xb) { u32x4 w; w.x = cvt_pk_bf16(v0[0], v0[1]); w.y = cvt_pk_bf16(v0[2], v0[3]); w.z = cvt_pk_bf16(v1[0], v1[1]); w.w = cvt_pk_bf16(v1[2], v1[3]); *(u32x4*)(xb + off + bj * HALF) = w;
                        sq += ((v0[0] * v0[0] + v0[1] * v0[1]) + (v0[2] * v0[2] + v0[3] * v0[3])) + ((v1[0] * v1[0] + v1[1] * v1[1]) + (v1[2] * v1[2] + v1[3] * v1[3])); } }
                if (xb) { sq += __shfl_xor(sq, 16); sq += __shfl_xor(sq, 32); if (fq == 0) atomicAdd(ssq + row, sq); }
                asm volatile("" ::: "memory"); } }
    }
};
struct EpiSwiglu {
    static constexpr bool PERM = true;
    bf16* O; int ldc; const float* ssq;
    __device__ __forceinline__ f32x2 prefetch(const Unit& u, int wr, int lane) const { f32x2 p; p.x = ssq[u.pm * BM + wr * 64 + lane]; p.y = ssq[u.pm * BM + HALF + wr * 64 + lane]; return p; }
    __device__ __forceinline__ void operator()(const f32x4 (&acc)[2][2][4][2], const Unit& u, int wr, int wc, int fr, int fq, f32x2 pre) const {
        const int row0 = u.pm * BM + wr * 64 + fr, col0 = u.pn * HALF + wc * 32 + 8 * fq;
#pragma unroll
        for (int ai = 0; ai < 2; ++ai) { if (u.half >= 0 && u.half != ai) continue;
#pragma unroll
            for (int m = 0; m < 4; ++m) { const int row = row0 + ai * HALF + m * 16; bf16* rowp = O + (size_t)row * ldc + col0;
                const float rs = __builtin_amdgcn_rsqf(__shfl(ai ? pre.y : pre.x, 16 * m + fr) * (1.0f / 2048.0f) + 1e-6f);
                float r[8];
#pragma unroll
                for (int n = 0; n < 2; ++n)
#pragma unroll
                    for (int j = 0; j < 4; ++j) { const float g = acc[ai][0][m][n][j] * rs, up = acc[ai][1][m][n][j] * rs; r[4 * n + j] = g * __builtin_amdgcn_rcpf(1.0f + __expf(-g)) * up; }
                u32x4 w; w.x = cvt_pk_bf16(r[0], r[1]); w.y = cvt_pk_bf16(r[2], r[3]); w.z = cvt_pk_bf16(r[4], r[5]); w.w = cvt_pk_bf16(r[6], r[7]);
                *(u32x4*)rowp = w; } }
    }
};

template <class Epi, bool ALIGN_EPI, bool SP2>
__device__ __forceinline__ void gemm_phase(LAS unsigned char* lds, const Gemm g, const StaticOrder& S, const Epi& E) {
    const int tid = threadIdx.x, wid = __builtin_amdgcn_readfirstlane(tid >> 6), lane = tid & 63, wr = wid >> 2, wc = wid & 3, fr = lane & 15, fq = lane >> 4;
    const int K = g.K, nt = K / BK;
    unsigned voffA[2], voffB[2];
#pragma unroll
    for (int i = 0; i < 2; ++i) { int R, C; stage_rc(tid * 16 + i * 8192, R, C); const int Rb = Epi::PERM ? ((R & ~31) + perm32(R & 31)) : R;
        voffA[i] = (unsigned)(R * g.lda + C) * 2u; voffB[i] = (unsigned)(Rb * g.ldb + C) * 2u; }
    const size_t kstep = (size_t)(BK * 2);
    const size_t hstepA = (size_t)HALF * g.lda * 2, hstepB = (size_t)HALF * g.ldb * 2;
    const size_t tstepA = 2 * hstepA, tstepB = 2 * hstepB;
    const unsigned ldsw = (unsigned)wid * 1024u;
    const int aoff = lds_byte(wr * 64 + fr, fq * 8), boff = lds_byte(wc * 32 + fr, fq * 8);
#define PG8_SA(b, h) (((b) * 2 + (h)) * HTB)
#define PG8_SB(b, h) ((4 + (b) * 2 + (h)) * HTB)
#define PG8_STAGE(bufoff, gbase, voff) do { _Pragma("unroll") for (int _i = 0; _i < 2; ++_i) \
        __builtin_amdgcn_global_load_lds((const unsigned*)((const char*)(gbase) + (voff)[_i]), (LAS unsigned*)(lds + (bufoff) + ldsw + _i * 8192), 16, 0, 0); } while (0)
#define PG8_LDA(dst, b, h) do { _Pragma("unroll") for (int m = 0; m < 4; ++m) _Pragma("unroll") for (int k = 0; k < 2; ++k) dst[m][k] = *(const LAS bf16x8*)(lds + PG8_SA(b, h) + aoff + m * 2048 + k * 1024); } while (0)
#define PG8_LDB(dst, b, h) do { _Pragma("unroll") for (int n = 0; n < 2; ++n) _Pragma("unroll") for (int k = 0; k < 2; ++k) dst[n][k] = *(const LAS bf16x8*)(lds + PG8_SB(b, h) + boff + n * 2048 + k * 1024); } while (0)
#define PG8_MMA(ai, bj, At, Bt) do { __builtin_amdgcn_s_setprio(1); _Pragma("unroll") for (int m = 0; m < 4; ++m) _Pragma("unroll") for (int n = 0; n < 2; ++n) _Pragma("unroll") for (int k = 0; k < 2; ++k) \
        acc[ai][bj][m][n] = __builtin_amdgcn_mfma_f32_16x16x32_bf16(Bt[n][k], At[m][k], acc[ai][bj][m][n], 0, 0, 0); __builtin_amdgcn_s_setprio(0); } while (0)
#define PG8_WAIT_V(n) asm volatile("s_waitcnt vmcnt(" #n ")" ::: "memory")
#define PG8_WAIT_L(n) asm volatile("s_waitcnt lgkmcnt(" #n ")" ::: "memory")
#define PG8_BAR __builtin_amdgcn_s_barrier()
#define PG8_SCHED __builtin_amdgcn_sched_barrier(0)
    Unit cur, nxt; int ui = 0;
    if (!S.next(0, cur)) return;
    f32x4 acc[2][2][4][2];
#pragma unroll
    for (int a = 0; a < 2; ++a)
#pragma unroll
        for (int b = 0; b < 2; ++b)
#pragma unroll
            for (int m = 0; m < 4; ++m)
#pragma unroll
                for (int n = 0; n < 2; ++n) acc[a][b][m][n] = (f32x4){0.f, 0.f, 0.f, 0.f};
    bf16x8 At[4][2], B0[2][2], B1[2][2];
    const char* cA = (const char*)g.A + (size_t)cur.pm * tstepA; const char* cB = (const char*)g.Bt + (size_t)cur.pn * tstepB;
    if constexpr (SP2) {
        PG8_STAGE(PG8_SB(0, 0), cB, voffB); PG8_STAGE(PG8_SB(0, 1), cB + hstepB, voffB); PG8_STAGE(PG8_SA(0, 0), cA, voffA); PG8_STAGE(PG8_SA(0, 1), cA + hstepA, voffA);
        if (wr == 1) PG8_BAR;
        PG8_WAIT_V(2); PG8_BAR;
        PG8_STAGE(PG8_SB(1, 0), cB + kstep, voffB); PG8_STAGE(PG8_SA(1, 0), cA + kstep, voffA); PG8_STAGE(PG8_SB(1, 1), cB + hstepB + kstep, voffB);
        PG8_WAIT_V(6); PG8_BAR;
    } else {
        PG8_STAGE(PG8_SB(0, 0), cB, voffB); PG8_STAGE(PG8_SA(0, 0), cA, voffA); PG8_STAGE(PG8_SB(0, 1), cB + hstepB, voffB); PG8_STAGE(PG8_SA(0, 1), cA + hstepA, voffA);
        if (wr == 1) PG8_BAR;
        PG8_WAIT_V(4); PG8_BAR;
        PG8_STAGE(PG8_SB(1, 0), cB + kstep, voffB); PG8_STAGE(PG8_SA(1, 0), cA + kstep, voffA); PG8_STAGE(PG8_SB(1, 1), cB + hstepB + kstep, voffB);
        PG8_WAIT_V(6); PG8_BAR;
    }
    for (;;) {
        const bool has_next = S.next(ui + 1, nxt);
        const char* nA = has_next ? (const char*)g.A + (size_t)nxt.pm * tstepA : cA; const char* nB = has_next ? (const char*)g.Bt + (size_t)nxt.pn * tstepB : cB;
        const f32x2 epre = E.prefetch(cur, wr, lane);
        const int uh = cur.half;
#define PG8_MMF0(At, B0, B1) do { PG8_MMA(0, 0, At, B0); PG8_MMA(0, 1, At, B1); } while (0)
#define PG8_MMF1(At, B0, B1) do { PG8_MMA(1, 0, At, B0); PG8_MMA(1, 1, At, B1); } while (0)
#define PG8_MMN(At, B0, B1) do { } while (0)
#define PG8_KLOOP(MM0, MM1) \
        for (int t = 0; t < nt; t += 2) { \
            const bool last = (t == nt - 2); \
            const char* a1 = cA + (size_t)(t + 1) * kstep; \
            const char* a2 = last ? nA : cA + (size_t)(t + 2) * kstep; const char* b2 = last ? nB : cB + (size_t)(t + 2) * kstep; \
            const char* a3 = a2 + kstep; const char* b3 = b2 + kstep; \
            if constexpr (SP2) { \
            PG8_LDB(B0, 0, 0); PG8_LDB(B1, 0, 1); PG8_SCHED; PG8_LDA(At, 0, 0); PG8_STAGE(PG8_SA(1, 1), a1 + hstepA, voffA); \
            PG8_WAIT_V(8); PG8_WAIT_L(0); PG8_BAR; MM0(At, B0, B1); PG8_BAR; PG8_SCHED; \
            PG8_LDA(At, 0, 1); PG8_STAGE(PG8_SB(0, 0), b2, voffB); PG8_STAGE(PG8_SB(0, 1), b2 + hstepB, voffB); PG8_STAGE(PG8_SA(0, 0), a2, voffA); \
            PG8_WAIT_V(8); PG8_WAIT_L(0); PG8_BAR; MM1(At, B0, B1); PG8_BAR; PG8_SCHED; \
            PG8_LDB(B0, 1, 0); PG8_LDB(B1, 1, 1); PG8_SCHED; PG8_LDA(At, 1, 0); PG8_STAGE(PG8_SA(0, 1), a2 + hstepA, voffA); \
            PG8_WAIT_V(8); PG8_WAIT_L(0); PG8_BAR; MM0(At, B0, B1); PG8_BAR; PG8_SCHED; \
            PG8_LDA(At, 1, 1); PG8_STAGE(PG8_SB(1, 0), b3, voffB); PG8_STAGE(PG8_SB(1, 1), b3 + hstepB, voffB); PG8_STAGE(PG8_SA(1, 0), a3, voffA); \
            PG8_WAIT_V(8); PG8_WAIT_L(0); PG8_BAR; MM1(At, B0, B1); PG8_BAR; PG8_SCHED; \
            } else { \
            PG8_LDB(B0, 0, 0); PG8_SCHED; PG8_LDA(At, 0, 0); PG8_STAGE(PG8_SA(1, 1), a1 + hstepA, voffA); \
            PG8_WAIT_L(8); PG8_BAR; PG8_WAIT_L(0); PG8_MMA(0, 0, At, B0); PG8_BAR; PG8_SCHED; \
            PG8_LDB(B1, 0, 1); PG8_STAGE(PG8_SB(0, 0), b2, voffB); \
            PG8_BAR; PG8_WAIT_L(0); PG8_MMA(0, 1, At, B1); PG8_BAR; \
            PG8_LDA(At, 0, 1); PG8_STAGE(PG8_SA(0, 0), a2, voffA); \
            PG8_BAR; PG8_WAIT_L(0); PG8_MMA(1, 0, At, B0); PG8_BAR; PG8_SCHED; \
            PG8_STAGE(PG8_SB(0, 1), b2 + hstepB, voffB); \
            PG8_WAIT_V(6); PG8_BAR; PG8_MMA(1, 1, At, B1); PG8_BAR; \
            PG8_LDB(B0, 1, 0); PG8_SCHED; PG8_LDA(At, 1, 0); PG8_STAGE(PG8_SA(0, 1), a2 + hstepA, voffA); \
            PG8_WAIT_L(8); PG8_BAR; PG8_WAIT_L(0); PG8_MMA(0, 0, At, B0); PG8_BAR; PG8_SCHED; \
            PG8_LDB(B1, 1, 1); PG8_STAGE(PG8_SB(1, 0), b3, voffB); \
            PG8_BAR; PG8_WAIT_L(0); PG8_MMA(0, 1, At, B1); PG8_BAR; \
            PG8_LDA(At, 1, 1); PG8_STAGE(PG8_SA(1, 0), a3, voffA); \
            PG8_BAR; PG8_WAIT_L(0); PG8_MMA(1, 0, At, B0); PG8_BAR; PG8_SCHED; \
            PG8_STAGE(PG8_SB(1, 1), b3 + hstepB, voffB); \
            PG8_WAIT_V(6); PG8_BAR; PG8_MMA(1, 1, At, B1); PG8_BAR; \
            } \
        }
        if (uh < 0) { PG8_KLOOP(PG8_MMF0, PG8_MMF1) } else if (uh == 0) { PG8_KLOOP(PG8_MMF0, PG8_MMN) } else { PG8_KLOOP(PG8_MMN, PG8_MMF1) }
#undef PG8_KLOOP
#undef PG8_MMF0
#undef PG8_MMF1
#undef PG8_MMN
        if constexpr (ALIGN_EPI) { if (wr == 0) PG8_BAR; }
        E(acc, cur, wr, wc, fr, fq, epre);
        if (!has_next) break;
#pragma unroll
        for (int a = 0; a < 2; ++a)
#pragma unroll
            for (int b = 0; b < 2; ++b)
#pragma unroll
                for (int m = 0; m < 4; ++m)
#pragma unroll
                    for (int n = 0; n < 2; ++n) acc[a][b][m][n] = (f32x4){0.f, 0.f, 0.f, 0.f};
        cur = nxt; cA = nA; cB = nB; ++ui;
        if constexpr (ALIGN_EPI) { if (wr == 1) PG8_BAR; }
    }
    PG8_WAIT_V(0);
    if constexpr (!ALIGN_EPI) { if (wr == 0) PG8_BAR; }
    PG8_BAR;
#undef PG8_SA
#undef PG8_SB
#undef PG8_STAGE
#undef PG8_LDA
#undef PG8_LDB
#undef PG8_MMA
#undef PG8_WAIT_V
#undef PG8_WAIT_L
#undef PG8_BAR
#undef PG8_SCHED
}
}

constexpr size_t SZ_WIN0 = (size_t)EVEN_IN * DM * 2, SZ_WOUT0 = (size_t)DM * DM * 2, SZ_WGU = (size_t)2 * FF * DM * 2, SZ_WD = (size_t)DM * FF * 2;
constexpr size_t SZ_WIN1 = (size_t)ODD_PAD * DM * 2, SZ_WOUT1 = (size_t)DM * DM * 2, SZ_WDSA = (size_t)3072 * 384 * 2, SZ_WUVT = (size_t)8 * 128 * 256 * 2;
constexpr size_t WS_CTL = 0, CTL_BYTES = 1u << 20, WS_BAR = WS_CTL + 896 * 1024, BAR_BYTES = 16384, WS_SSQ = WS_CTL + 512 * 1024, WS_QCNT = WS_CTL + 640 * 1024, WS_SGST = WS_CTL + 704 * 1024;
constexpr size_t WS_WIN1 = WS_CTL + CTL_BYTES, WS_WOUT1 = WS_WIN1 + SZ_WIN1, WS_WGU1 = WS_WOUT1 + SZ_WOUT1, WS_WD1 = WS_WGU1 + SZ_WGU, WS_WDSA = WS_WD1 + SZ_WD;
constexpr size_t WS_WUVT = WS_WDSA + SZ_WDSA;
constexpr size_t WS_B = WS_WUVT + SZ_WUVT;
constexpr size_t WS_WIN0 = WS_B, WS_WOUT0 = WS_WIN0 + SZ_WIN0, WS_WGU0 = WS_WOUT0 + SZ_WOUT0, WS_WD0 = WS_WGU0 + SZ_WGU, WS_B_END = WS_WD0 + SZ_WD;
constexpr size_t WS_MIX1 = WS_B, WS_QRAW = WS_MIX1 + (size_t)M * 2048 * 2, WS_QI = WS_QRAW + (size_t)M * 2048 * 2;
static_assert(WS_QI + (size_t)M * 1024 * 2 <= WS_B_END, "layer-1 overlay fits in the layer-0 weight region");
constexpr size_t WS_XN = WS_B_END;
constexpr size_t WS_Z = WS_XN + (size_t)M * DM * 2;
constexpr size_t WS_X1 = WS_Z + (size_t)M * EVEN_IN * 2;
constexpr size_t WS_RAW = WS_X1 + (size_t)M * DM * 4;
constexpr size_t WS_MIX0 = WS_RAW + (size_t)M * 1024 * 2;
constexpr size_t WS_KVN = WS_MIX0, WS_SEL = WS_KVN + (size_t)M * 256 * 2, WS_NSEL = WS_SEL + (size_t)M * 256 * 2, WS_MSCQ = WS_NSEL + (size_t)M * 4, WS_KIDXF = WS_MSCQ + (size_t)M * 4;
constexpr size_t WS_ROPE = WS_MIX0 + (size_t)M * DM * 2;
constexpr size_t WS_END = WS_ROPE + (size_t)2 * SEQ * 128 * 4;
static_assert(WS_KIDXF + (size_t)M * 128 <= WS_ROPE, "layer-1 small buffers fit in MIX0");
static_assert(WS_END <= 473360896ull, "workspace map exceeds the guaranteed d_ws size");

constexpr int LDS_BYTES = 163840;
constexpr int NPHASES = 17;

struct Args {
    const float* in[23];
    float* out; unsigned char* ws;
    int ph_lo, ph_hi, flags, pad;
};
enum { I_X = 0, I_LN_MIX, I_LN_FFN, I_WG, I_WU, I_WD, I_RELB, I_EV_WIN, I_EV_WOUT, I_SGU_LNG, I_SGU_LNB, I_SGU_WS, I_SGU_BS, I_OD_WIN, I_OD_WOUT, I_HG_LB, I_HG_NG,
       I_CQ_G, I_CKV_G, I_W_UQ, I_QN_G, I_W_QIDX, I_W_UV };

__device__ __forceinline__ f32x4 mma_tile(const LAS bf16* A, int lda, const LAS bf16* B, int ldb, int ksteps, f32x4 acc, int r, int g) {
    const LAS bf16* pa = A + r * lda + g * 8; const LAS bf16* pb = B + r * ldb + g * 8;
    for (int s = 0; s < ksteps; ++s) {
        const bf16x8 a = *(const LAS bf16x8*)(pa + s * 32); const bf16x8 b = *(const LAS bf16x8*)(pb + s * 32);
        acc = __builtin_amdgcn_mfma_f32_16x16x32_bf16(a, b, acc, 0, 0, 0);
    }
    return acc;
}


#define XB_TMO      128
#define XB_XCNT(j)  (256  + 64 * (j))
#define XB_XSUB(j)  (1280 + 64 * (j))
#define XB_XGEN(j)  (2304 + 64 * (j))
#define XB_TOP      3328
#define XB_TOPGEN   3392
#define XCD_BAR_WORDS 3456
#define XB_SPIN_CAP (1u << 20)
__device__ __forceinline__ unsigned xb_ld(unsigned* p)              { return __hip_atomic_load(p, __ATOMIC_RELAXED, __HIP_MEMORY_SCOPE_AGENT); }
__device__ __forceinline__ unsigned xb_add(unsigned* p, unsigned v) { return __hip_atomic_fetch_add(p, v, __ATOMIC_RELAXED, __HIP_MEMORY_SCOPE_AGENT); }
__device__ __forceinline__ unsigned xb_xcc_id() { return (unsigned)__builtin_amdgcn_s_getreg((3 << 11) | 20) & 0xFu; }
#define XB_SPIN(cond, bar) do { unsigned _sp = 0; while (cond) { __builtin_amdgcn_s_sleep(1); \
    if ((++_sp & 255u) == 0u) { if (xb_ld(&(bar)[XB_TMO])) break; if (_sp > XB_SPIN_CAP) { atomicAdd(&(bar)[XB_TMO], 1u); break; } } } } while (0)
struct XcdBarrier { unsigned* bar; unsigned x; volatile LAS unsigned* st; };
__device__ __forceinline__ XcdBarrier xcd_barrier_post(unsigned* bar, volatile LAS unsigned* st) {
    XcdBarrier b; b.bar = bar; b.x = xb_xcc_id(); b.st = st;
    if (threadIdx.x == 0) (void)xb_add(&bar[XB_XCNT(b.x)], 1u);
    return b;
}
__device__ __forceinline__ void xcd_barrier_complete(unsigned* bar, unsigned x, unsigned& nloc, unsigned& nx) {
    const unsigned G = gridDim.x * gridDim.y * gridDim.z;
    unsigned sum, cnt, mine, sp = 0u;
    for (;;) {
        sum = 0u; cnt = 0u; mine = 0u;
#pragma unroll
        for (unsigned j = 0; j < 16; ++j) { const unsigned c = xb_ld(&bar[XB_XCNT(j)]); sum += c; cnt += (c > 0u) ? 1u : 0u; mine = (j == x) ? c : mine; }
        if (sum == G) break;
        __builtin_amdgcn_s_sleep(1);
        if ((++sp & 255u) == 0u) { if (xb_ld(&bar[XB_TMO])) break; if (sp > XB_SPIN_CAP) { atomicAdd(&bar[XB_TMO], 1u); break; } }
    }
    nloc = mine > 0u ? mine : 1u; nx = cnt > 0u ? cnt : 1u;
}
__device__ __forceinline__ void xcd_barrier(const XcdBarrier& b) {
    asm volatile("s_waitcnt vmcnt(0)" ::: "memory");
    __syncthreads();
    if (threadIdx.x == 0) {
        unsigned* bar = b.bar;
        __builtin_amdgcn_s_waitcnt(0);
        unsigned nloc = b.st[0], nx = b.st[1];
        if (nloc == 0u) { xcd_barrier_complete(bar, b.x, nloc, nx); b.st[0] = nloc; b.st[1] = nx; }
        const unsigned old = xb_add(&bar[XB_XSUB(b.x)], 1u);
        const unsigned gen = old / nloc;
        if (old + 1u == (gen + 1u) * nloc) {
            __builtin_amdgcn_fence(__ATOMIC_RELEASE, "agent");
            asm volatile("s_waitcnt vmcnt(0)" ::: "memory");
            const unsigned og = xb_add(&bar[XB_TOP], 1u);
            const unsigned tg = og / nx;
            if (og + 1u == (tg + 1u) * nx) xb_add(&bar[XB_TOPGEN], 1u);
            else XB_SPIN(xb_ld(&bar[XB_TOPGEN]) == tg, bar);
            __builtin_amdgcn_fence(__ATOMIC_ACQUIRE, "agent");
            xb_add(&bar[XB_XGEN(b.x)], 1u);
            asm volatile("s_waitcnt vmcnt(0)" ::: "memory");
        } else {
            XB_SPIN(xb_ld(&bar[XB_XGEN(b.x)]) == gen, bar);
            __builtin_amdgcn_fence(__ATOMIC_ACQUIRE, "agent");
            asm volatile("s_waitcnt vmcnt(0)" ::: "memory");
        }
    }
    __syncthreads();
}

struct TrD { const float* W; const float* ks; bf16* WT; int N, ldd, row_off, mode, k0, n0; };
#ifndef CONV_NKG
#define CONV_NKG 4
#endif
__device__ __forceinline__ void tr_set(TrD& d, const float* W, int N, bf16* WT, int ldd, int row_off, int mode, const float* ks, int item, bool G8 = false) {
    const int nblk = (N + 63) >> 6; int kb, nb;
    if (G8) { constexpr int NKG = CONV_NKG, NNG = 8 / NKG; const int sub = item & 7, grp = item >> 3, nb2 = nblk / NNG, gk = grp / nb2; kb = NKG * gk + sub / NNG; nb = NNG * (grp - gk * nb2) + sub % NNG; }
    else { kb = item / nblk; nb = item - kb * nblk; }
    d.W = W; d.ks = ks; d.WT = WT; d.N = N; d.ldd = ldd; d.row_off = row_off; d.mode = mode; d.k0 = 64 * kb; d.n0 = 64 * nb;
}
__device__ __forceinline__ void tr_load(const TrD& d, f32x4 (&R)[16], int lane) {
    const int n = d.n0 + 4 * (lane & 15); const bool ok = n < d.N;
    const float* p = d.W + (size_t)(d.k0 + (lane >> 4)) * d.N + n;
#pragma unroll
    for (int i = 0; i < 16; ++i) R[i] = ok ? __builtin_nontemporal_load((const f32x4*)(p + (size_t)(4 * i) * d.N)) : (f32x4){0.f, 0.f, 0.f, 0.f};
}
template <bool NT>
__device__ __forceinline__ void tr_finish(const TrD& d, const f32x4 (&R)[16], LAS float* scr, int lane) {
#pragma unroll
    for (int i = 0; i < 16; ++i) { const int kk = 4 * i + (lane >> 4); *(LAS f32x4*)(scr + kk * 68 + 4 * (kk >> 3) + 4 * (lane & 15)) = R[i]; }
    LDS_WAIT(); asm volatile("" ::: "memory");
    const int c = lane & 7; const LAS float* s = scr + (8 * c) * 68 + 4 * c;
    f32x4 g0 = (f32x4){1.f, 1.f, 1.f, 1.f}, g1 = g0;
    if (d.ks) { g0 = *(const f32x4*)(d.ks + d.k0 + 8 * c); g1 = *(const f32x4*)(d.ks + d.k0 + 8 * c + 4); }
#pragma unroll
    for (int j = 0; j < 8; ++j) { const int nl = (lane >> 3) + 8 * j, n = d.n0 + nl;
        u32x4 o; o.x = pk2(s[0 * 68 + nl] * g0.x, s[1 * 68 + nl] * g0.y); o.y = pk2(s[2 * 68 + nl] * g0.z, s[3 * 68 + nl] * g0.w);
        o.z = pk2(s[4 * 68 + nl] * g1.x, s[5 * 68 + nl] * g1.y); o.w = pk2(s[6 * 68 + nl] * g1.z, s[7 * 68 + nl] * g1.w);
        const int mr = (d.mode == 0) ? n : (256 * (n >> 7) + (n & 127) + (d.mode == 2 ? 128 : 0));
        if (n < d.N) { u32x4* dst = (u32x4*)(d.WT + (size_t)(d.row_off + mr) * d.ldd + d.k0 + 8 * c);
            if (d.mode == 3) { const int ng = d.row_off + n, kf = d.k0 + 8 * c;
                dst = (u32x4*)d.WT + ((size_t)((ng >> 4) * (d.ldd >> 5) + (kf >> 5)) * 64 + 16 * ((kf >> 3) & 3) + (ng & 15)); } if (NT) __builtin_nontemporal_store(o, dst); else *dst = o; } }
    LDS_WAIT(); asm volatile("" ::: "memory");
}
__device__ __forceinline__ void rms_row_to_bf16(const float* xrow, const float* gain, bf16* orow, int lane) {
    const f32x4* xr = (const f32x4*)xrow + lane; const f32x4* gr = (const f32x4*)gain + lane;
    f32x4 v[8]; float s = 0.f;
#pragma unroll
    for (int j = 0; j < 8; ++j) { v[j] = xr[64 * j]; s += (v[j].x * v[j].x + v[j].y * v[j].y) + (v[j].z * v[j].z + v[j].w * v[j].w); }
    const float rstd = __builtin_amdgcn_rsqf(wave_sum(s) * (1.0f / DM) + EPS);
    u32x2* o8 = (u32x2*)orow + lane;
#pragma unroll
    for (int j = 0; j < 8; ++j) { const f32x4 gg = gr[64 * j]; u32x2 w; w.x = pk2(v[j].x * rstd * gg.x, v[j].y * rstd * gg.y); w.y = pk2(v[j].z * rstd * gg.z, v[j].w * rstd * gg.w); o8[64 * j] = w; }
}
__device__ __forceinline__ void norm_rows(const float* X, const float* gain, bf16* XN, int gw, int NGW, int lane) {
    asm volatile("" : "+v"(lane));
    const f32x4* gr = (const f32x4*)gain + lane;
    for (int m0 = gw; m0 < M; m0 += 4 * NGW) {
        f32x4 v[4][8];
#pragma unroll
        for (int q = 0; q < 4; ++q) { const int m = (m0 + q * NGW < M) ? m0 + q * NGW : m0; const f32x4* xr = (const f32x4*)(X + (size_t)m * DM) + lane;
#pragma unroll
            for (int j = 0; j < 8; ++j) v[q][j] = xr[64 * j]; }
#pragma unroll
        for (int q = 0; q < 4; ++q) { const int m = m0 + q * NGW; if (m >= M) break;
            float s = 0.f;
#pragma unroll
            for (int j = 0; j < 8; ++j) s += (v[q][j].x * v[q][j].x + v[q][j].y * v[q][j].y) + (v[q][j].z * v[q][j].z + v[q][j].w * v[q][j].w);
            const float rstd = __builtin_amdgcn_rsqf(wave_sum(s) * (1.0f / DM) + EPS);
            u32x2* o8 = (u32x2*)(XN + (size_t)m * DM) + lane;
#pragma unroll
            for (int j = 0; j < 8; ++j) { const f32x4 gg = gr[64 * j]; u32x2 w; w.x = pk2(v[q][j].x * rstd * gg.x, v[q][j].y * rstd * gg.y); w.y = pk2(v[q][j].z * rstd * gg.z, v[q][j].w * rstd * gg.w); o8[64 * j] = w; } }
    }
}


template <int SET>
__device__ __forceinline__ bool conv_desc(const Args& a, int r, TrD& d) {
    unsigned char* ws = a.ws;
    constexpr int J_IN0 = (DM / 64) * (EVEN_IN / 64), J_SQ = (DM / 64) * (DM / 64), J_GU = (DM / 64) * (FF / 64), J_DN = (FF / 64) * (DM / 64), J_IN1 = (DM / 64) * ((ODD_IN + 63) / 64),
                  J_UQ = (384 / 64) * (2048 / 64), J_QI = (384 / 64) * (1024 / 64), J_UV = 8 * (256 / 64) * (128 / 64);
    const float* wg = a.in[I_WG]; const float* wu = a.in[I_WU]; const float* wd = a.in[I_WD];
    if (r < 0) return false;
    if (SET == 0) { if (r >= J_IN0) return false; tr_set(d, a.in[I_EV_WIN], EVEN_IN, (bf16*)(ws + WS_WIN0), DM, 0, 0, nullptr, r, true); return true; }
    if (SET == 1) {
        if (r < J_SQ) { tr_set(d, a.in[I_EV_WOUT], DM, (bf16*)(ws + WS_WOUT0), DM, 0, 0, nullptr, r, true); return true; } r -= J_SQ;
        if (r < J_GU) { tr_set(d, wg, FF, (bf16*)(ws + WS_WGU0), DM, 0, 1, a.in[I_LN_FFN], r, true); return true; } r -= J_GU;
        if (r < J_GU) { tr_set(d, wu, FF, (bf16*)(ws + WS_WGU0), DM, 0, 2, a.in[I_LN_FFN], r, true); return true; } r -= J_GU;
        if (r < J_DN) { tr_set(d, wd, DM, (bf16*)(ws + WS_WD0), FF, 0, 0, nullptr, r, true); return true; } r -= J_DN;
        if (r < J_IN1) { tr_set(d, a.in[I_OD_WIN], ODD_IN, (bf16*)(ws + WS_WIN1), DM, 0, 0, a.in[I_LN_MIX] + DM, r, true); return true; } r -= J_IN1;
        if (r < J_UQ) { tr_set(d, a.in[I_W_UQ], 2048, (bf16*)(ws + WS_WDSA), 384, 0, 0, a.in[I_CQ_G], r); return true; } r -= J_UQ;
        if (r < J_QI) { tr_set(d, a.in[I_W_QIDX], 1024, (bf16*)(ws + WS_WDSA), 384, 2048, 0, a.in[I_CQ_G], r); return true; }
        return false; }
    if (SET == 3) {
        if (r < J_GU) { tr_set(d, wg + (size_t)DM * FF, FF, (bf16*)(ws + WS_WGU1), DM, 0, 1, a.in[I_LN_FFN] + DM, r, true); return true; } r -= J_GU;
        if (r < J_GU) { tr_set(d, wu + (size_t)DM * FF, FF, (bf16*)(ws + WS_WGU1), DM, 0, 2, a.in[I_LN_FFN] + DM, r, true); return true; }
        return false; }
    if (r < J_DN) { tr_set(d, wd + (size_t)FF * DM, DM, (bf16*)(ws + WS_WD1), FF, 0, 0, nullptr, r, true); return true; } r -= J_DN;
    if (r < J_SQ) { tr_set(d, a.in[I_OD_WOUT], DM, (bf16*)(ws + WS_WOUT1), DM, 0, 0, nullptr, r, true); return true; } r -= J_SQ;
    if (r < J_UV) { const int h = r >> 3; tr_set(d, a.in[I_W_UV] + (size_t)h * 256 * 128, 128, (bf16*)(ws + WS_WUVT), 256, 128 * h, 3, nullptr, r & 7); return true; }
    return false;
}
template <int SET>
__device__ __forceinline__ void conv_set(const Args& a, LAS unsigned char* lds, int tid, int lane, int wave, int gwv, int ngw, int gth, int nth, int base = 0, int lim = 1 << 30) {
    LAS float* scr = (LAS float*)(lds + wave * 17920);
    asm volatile("" : "+v"(lane));
    TrD d0, d1; f32x4 R0[16], R1[16];
    int it = base + gwv; bool v0 = it < lim && conv_desc<SET>(a, it, d0);
    if (v0) tr_load(d0, R0, lane);
    while (v0) {
        const bool v1 = it + ngw < lim && conv_desc<SET>(a, it + ngw, d1);
        if (v1) tr_load(d1, R1, lane);
        tr_finish<SET != 0>(d0, R0, scr, lane);
        if (!v1) break;
        it += 2 * ngw; v0 = it < lim && conv_desc<SET>(a, it, d0);
        if (v0) tr_load(d0, R0, lane);
        tr_finish<SET != 0>(d1, R1, scr, lane);
    }
    if (SET == 1 && nth > 0) {
        const size_t n16 = (size_t)(ODD_PAD - ODD_IN) * DM * 2 / 16; u32x4* p = (u32x4*)((bf16*)(a.ws + WS_WIN1) + (size_t)ODD_IN * DM);
        for (size_t i = gth; i < n16; i += nth) p[i] = (u32x4){0u, 0u, 0u, 0u}; }
}
__device__ __forceinline__ void p0_prologue(const Args& a, LAS unsigned char* lds, int tid, int lane, int wave, int G) {
    unsigned char* ws = a.ws;
    const int gw = blockIdx.x * 8 + wave, NGW = G * 8;
    conv_set<0>(a, lds, tid, lane, wave, gw, NGW, blockIdx.x * 512 + tid, G * 512);
    for (int i = blockIdx.x * 512 + tid; i < 3 * M; i += G * 512) ((float*)(ws + WS_SSQ))[i] = 0.f;
    if (blockIdx.x == 0 && tid < 64) ((unsigned*)(ws + WS_QCNT))[tid] = 0u;
    { float* ct = (float*)(ws + WS_ROPE); float* st = ct + (size_t)SEQ * 128;
      for (int u = blockIdx.x * 512 + tid; u < SEQ * 128; u += G * 512) { const int t = u >> 7, i = u & 127;
          const float inv = powf(10000.0f, -(float)(2 * i) / 256.0f); const float ang = (float)t * inv; float s, c; sincosf(ang, &s, &c); ct[u] = c; st[u] = s; } }
    norm_rows(a.in[I_X], a.in[I_LN_MIX], (bf16*)(ws + WS_XN), gw, NGW, lane);
}

constexpr size_t WS_QE = WS_X1, WS_KST = WS_QE + (size_t)16 * 1024 * 1024, WS_VTT = WS_KST + (size_t)16 * 1024 * 1024, WS_INTRA = WS_VTT + (size_t)16 * 1024 * 1024, WS_DEC = WS_CTL;
constexpr size_t WS_OBUF = WS_X1;
static_assert(WS_INTRA + (size_t)M * 1024 * 2 <= WS_X1 + (size_t)M * DM * 4 && (size_t)1024 * 128 * 4 <= CTL_BYTES, "scan scratch fits in X1 / CTL");

template <int DK, bool HG>
__device__ __forceinline__ void prep_item(const Args& a, LAS unsigned char* lds, int item, int tid, int lane, int wave) {
    constexpr int DV = DK, LQ = DK + 8, LT = 72, KS = DK / 32, NH = HG ? 8 : 4;
    constexpr int O_QE = 0, O_KE = O_QE + 64 * LQ * 2, O_KST = O_KE + 64 * LQ * 2, O_VT = O_KST + DK * LT * 2, O_P = O_VT + DV * LT * 2, O_TAB = O_P + 64 * LT * 2;
    static_assert(O_TAB + 4096 <= LDS_BYTES, "prep LDS map");
    LAS bf16* Qe = (LAS bf16*)(lds + O_QE); LAS bf16* Ke = (LAS bf16*)(lds + O_KE); LAS bf16* KsT = (LAS bf16*)(lds + O_KST); LAS bf16* VT = (LAS bf16*)(lds + O_VT);
    LAS bf16* Pm = (LAS bf16*)(lds + O_P); LAS float* TAB = (LAS float*)(lds + O_TAB);
    const int r = lane & 15, g = lane >> 4;
    const int c = item & 63, bh = item >> 6, b = bh / NH, h = bh % NH;
    const bf16* Z = (const bf16*)(a.ws + WS_Z);
    const int ldz = HG ? ODD_PAD : EVEN_IN, cq = HG ? (Z1_HQ + h * 128) : (h * 256), ck = HG ? (Z1_HF + h * 128) : (1024 + h * 256), cv = HG ? (Z1_HI + h * 128) : (2048 + h * 256);
    const size_t t0 = (size_t)b * SEQ + (size_t)c * 64;
    bf16* RAW = (bf16*)(a.ws + WS_INTRA);
    if (!HG) { const float lgam = log2f(1.0f - exp2f(-5.0f - (float)h)); if (tid < 65) TAB[tid] = exp2f(lgam * (float)tid); }
#pragma unroll
    for (int k = 0; k < DV / 64; ++k) { const int eg = wave + 8 * k, i = lane; const u32x4 rv = *(const u32x4*)(Z + (t0 + i) * ldz + cv + 8 * eg);
#pragma unroll
        for (int e = 0; e < 4; ++e) { VT[(8 * eg + 2 * e) * LT + i] = (bf16)(rv[e] & 0xffffu); VT[(8 * eg + 2 * e + 1) * LT + i] = (bf16)(rv[e] >> 16); } }
    if (!HG) {
        __syncthreads();
#pragma unroll
        for (int k = 0; k < 2; ++k) { const int d0 = 8 * (wave + 8 * k), i = lane; const bf16* zr = Z + (t0 + i) * ldz;
            const u32x4 rq1 = *(const u32x4*)(zr + cq + d0), rq2 = *(const u32x4*)(zr + cq + 128 + d0), rk1 = *(const u32x4*)(zr + ck + d0), rk2 = *(const u32x4*)(zr + ck + 128 + d0);
            const float* cp = (const float*)(a.ws + WS_ROPE) + (size_t)(c * 64 + i) * 128 + d0; const float* sp = cp + (size_t)SEQ * 128;
            const f32x4 c0 = *(const f32x4*)cp, c1 = *(const f32x4*)(cp + 4), s0 = *(const f32x4*)sp, s1 = *(const f32x4*)(sp + 4);
            const float zeta = TAB[63 - i];
            float q1[8], q2[8], k1[8], k2[8], cs[8], sn[8];
#pragma unroll
            for (int e = 0; e < 4; ++e) { q1[2 * e] = bflo(rq1[e]); q1[2 * e + 1] = bfhi(rq1[e]); q2[2 * e] = bflo(rq2[e]); q2[2 * e + 1] = bfhi(rq2[e]);
                k1[2 * e] = bflo(rk1[e]); k1[2 * e + 1] = bfhi(rk1[e]); k2[2 * e] = bflo(rk2[e]); k2[2 * e + 1] = bfhi(rk2[e]);
                cs[e] = c0[e]; cs[4 + e] = c1[e]; sn[e] = s0[e]; sn[4 + e] = s1[e]; }
            float qa[8], qb[8], ka[8], kb[8];
#pragma unroll
            for (int e = 0; e < 8; ++e) { qa[e] = q1[e] * cs[e] - q2[e] * sn[e]; qb[e] = q1[e] * sn[e] + q2[e] * cs[e];
                ka[e] = (k1[e] * cs[e] - k2[e] * sn[e]) * 0.0625f; kb[e] = (k1[e] * sn[e] + k2[e] * cs[e]) * 0.0625f; }
            u32x4 w;
            w.x = pk2(qa[0], qa[1]); w.y = pk2(qa[2], qa[3]); w.z = pk2(qa[4], qa[5]); w.w = pk2(qa[6], qa[7]); *(LAS u32x4*)(Qe + i * LQ + d0) = w;
            w.x = pk2(qb[0], qb[1]); w.y = pk2(qb[2], qb[3]); w.z = pk2(qb[4], qb[5]); w.w = pk2(qb[6], qb[7]); *(LAS u32x4*)(Qe + i * LQ + 128 + d0) = w;
            w.x = pk2(ka[0], ka[1]); w.y = pk2(ka[2], ka[3]); w.z = pk2(ka[4], ka[5]); w.w = pk2(ka[6], ka[7]); *(LAS u32x4*)(Ke + i * LQ + d0) = w;
            w.x = pk2(kb[0], kb[1]); w.y = pk2(kb[2], kb[3]); w.z = pk2(kb[4], kb[5]); w.w = pk2(kb[6], kb[7]); *(LAS u32x4*)(Ke + i * LQ + 128 + d0) = w;
#pragma unroll
            for (int e = 0; e < 8; ++e) { KsT[(d0 + e) * LT + i] = f2bf1(ka[e] * zeta); KsT[(128 + d0 + e) * LT + i] = f2bf1(kb[e] * zeta); }
        }
    } else {
        const int d = tid & 127, seg = tid >> 7;
        const float l0 = a.in[I_HG_LB][h * 128 + d], l1 = a.in[I_HG_LB][1024 + h * 128 + d]; const float lb = __builtin_amdgcn_rcpf(1.0f + __expf(l0 - l1));
        unsigned rfq[16];
#pragma unroll
        for (int tt = 0; tt < 16; ++tt) { const bf16* zr = Z + (t0 + 16 * seg + tt) * ldz; rfq[tt] = (unsigned)zr[ck + d] | ((unsigned)zr[cq + d] << 16); }
        float cs[16], om[16]; float run = 0.f;
#pragma unroll
        for (int tt = 0; tt < 16; ++tt) { const float fl = bflo(rfq[tt]); const float sg = __builtin_amdgcn_rcpf(1.0f + __expf(-fl)); const float f = lb + (1.0f - lb) * sg;
            om[tt] = (1.0f - lb) * (1.0f - sg); run += __logf(f); cs[tt] = run; }
        TAB[256 + seg * 128 + d] = run;
        __syncthreads();
        float off = 0.f, tot = 0.f;
#pragma unroll
        for (int s2 = 0; s2 < 4; ++s2) { const float v = TAB[256 + s2 * 128 + d]; tot += v; if (s2 < seg) off += v; }
        if (seg == 0) TAB[d] = __expf(tot);
        float ks[16];
#pragma unroll
        for (int tt = 0; tt < 16; ++tt) { const float bc = fmaxf(off + cs[tt], -80.0f); const float qv = bfhi(rfq[tt]); const float qs = qv * __builtin_amdgcn_rcpf(1.0f + __expf(-qv));
            const int t = 16 * seg + tt;
            Qe[t * LQ + d] = f2bf1(qs * __expf(bc)); Ke[t * LQ + d] = f2bf1(om[tt] * __expf(-bc)); ks[tt] = om[tt] * __expf(fmaxf(tot, -80.0f) - bc); }
        u32x4 w;
        w.x = pk2(ks[0], ks[1]); w.y = pk2(ks[2], ks[3]); w.z = pk2(ks[4], ks[5]); w.w = pk2(ks[6], ks[7]); *(LAS u32x4*)(KsT + d * LT + 16 * seg) = w;
        w.x = pk2(ks[8], ks[9]); w.y = pk2(ks[10], ks[11]); w.z = pk2(ks[12], ks[13]); w.w = pk2(ks[14], ks[15]); *(LAS u32x4*)(KsT + d * LT + 16 * seg + 8) = w;
    }
    __syncthreads();
#pragma unroll
    for (int tt = 0; tt < 2; ++tt) { const int t = 2 * wave + tt, ti = t >> 2, tj = t & 3;
        f32x4 s = mma_tile(Ke + 16 * tj * LQ, LQ, Qe + 16 * ti * LQ, LQ, KS, (f32x4){0.f, 0.f, 0.f, 0.f}, r, g);
        const int i = 16 * ti + r;
#pragma unroll
        for (int jj = 0; jj < 4; ++jj) { const int j = 16 * tj + 4 * g + jj;
            if (!HG) { const int dd = i > j ? i - j : j - i; s[jj] *= TAB[dd]; } else { if (j > i) s[jj] = 0.f; } }
        u32x2 w; w.x = pk2(s[0], s[1]); w.y = pk2(s[2], s[3]); *(LAS u32x2*)(Pm + i * LT + 16 * tj + 4 * g) = w; }
    __syncthreads();
#pragma unroll
    for (int k = 0; k < DV / 32; ++k) { const int t = wave + 8 * k, ti = t & 3, te = t >> 2;
        const f32x4 o = mma_tile(VT + 16 * te * LT, LT, Pm + 16 * ti * LT, LT, 2, (f32x4){0.f, 0.f, 0.f, 0.f}, r, g);
        u32x2 w; w.x = pk2(o[0], o[1]); w.y = pk2(o[2], o[3]);
        ((u32x2*)RAW)[(((size_t)item * (DV / 16) + te) * 4 + ti) * 64 + lane] = w; }
    { bf16* QEg = (bf16*)(a.ws + WS_QE) + (size_t)item * 64 * DK; bf16* KSTg = (bf16*)(a.ws + WS_KST) + (size_t)item * DK * 64; bf16* VTTg = (bf16*)(a.ws + WS_VTT) + (size_t)item * DV * 64;
#pragma unroll
      for (int k = 0; k < DK / 64; ++k) { const int u = tid + 512 * k; const int i = u / (DK / 8), cc = u % (DK / 8);
          *(u32x4*)(QEg + (size_t)u * 8) = *(const LAS u32x4*)(Qe + i * LQ + 8 * cc);
          const int d = u >> 3, c8 = u & 7;
          { const int fr = u & 15, fg = (u >> 4) & 3, fs = (u >> 6) & 1, fd = u >> 7;
            *(u32x4*)(KSTg + (size_t)u * 8) = *(const LAS u32x4*)(KsT + (16 * fd + fr) * LT + 8 * (4 * fs + fg)); }
          *(u32x4*)(VTTg + (size_t)u * 8) = *(const LAS u32x4*)(VT + d * LT + 8 * c8); }
      if (HG && tid < 128) ((float*)(a.ws + WS_DEC))[(size_t)item * 128 + tid] = TAB[tid]; }
    __syncthreads();
}

template <int DK, bool HG>
__device__ __forceinline__ void scan_item(const Args& a, LAS unsigned char* lds, int item, int tid, int lane, int wave) {
    constexpr int DV = DK, LQ = DK + 8, LT = 72, KS = DK / 32, DT = DK / 128, NH = HG ? 8 : 4, NSL = DV / 32, NU = DK / 64;
    constexpr int O_QE = 0, O_KST = O_QE + 64 * LQ * 2, O_VT = O_KST + DK * LT * 2, O_STB = O_VT + 32 * LT * 2, O_TAB = O_STB + 32 * LQ * 2;
    LAS bf16* Qe = (LAS bf16*)(lds + O_QE); LAS bf16* KsT = (LAS bf16*)(lds + O_KST); LAS bf16* VT = (LAS bf16*)(lds + O_VT);
    LAS bf16* STb = (LAS bf16*)(lds + O_STB); LAS float* TAB = (LAS float*)(lds + O_TAB);
    const int r = lane & 15, g = lane >> 4;
    constexpr int NBH = 64 / NSL;
    const int bh = item % NBH, sl = item / NBH, b = bh / NH, h = bh % NH;
    bf16* RAW = (bf16*)(a.ws + WS_RAW);
    const bf16* QEg = (const bf16*)(a.ws + WS_QE) + (size_t)bh * 64 * 64 * DK; const bf16* KSTg = (const bf16*)(a.ws + WS_KST) + (size_t)bh * 64 * DK * 64;
    const bf16* VTTg = (const bf16*)(a.ws + WS_VTT) + (size_t)bh * 64 * DV * 64 + (size_t)sl * 32 * 64; const float* DECg = (const float*)(a.ws + WS_DEC) + (size_t)bh * 64 * 128;
    if (!HG) { const float lgam = log2f(1.0f - exp2f(-5.0f - (float)h)); if (tid < 65) TAB[tid] = exp2f(lgam * (float)tid); }
    f32x4 st[DT][2];
#pragma unroll
    for (int dt = 0; dt < DT; ++dt) { st[dt][0] = (f32x4){0.f, 0.f, 0.f, 0.f}; st[dt][1] = (f32x4){0.f, 0.f, 0.f, 0.f}; }
    const int dbase = wave * (DK / 8), ti = wave >> 1, te = wave & 1;
    const size_t tok0 = (size_t)b * SEQ;
    bf16* outp = RAW + (tok0 + 16 * ti + r) * 1024 + h * DV + sl * 32 + 16 * te + 4 * g;
    const char* inb = (const char*)(a.ws + WS_INTRA) + ((size_t)(bh * 64) * (DV / 16) + 2 * sl) * 2048;
    const unsigned inl = (unsigned)((te * 4 + ti) * 64 + lane) * 8u;
    u32x4 rqeA[NU], rksA[NU], rvtA, rqeB[NU], rksB[NU], rvtB, rqeC[NU], rksC[NU], rvtC, rqeD[NU], rksD[NU], rvtD; u32x2 rinA, rinB, rinC, rinD; f32x4 rdecA[DT], rdecB[DT], rdecC[DT], rdecD[DT];
#define SCAN_LOAD_K(c_, rks) do { \
        _Pragma("unroll") for (int dt = 0; dt < DT; ++dt) _Pragma("unroll") for (int s2 = 0; s2 < 2; ++s2) \
            rks[2 * dt + s2] = *(const u32x4*)(KSTg + (size_t)(c_) * DK * 64 + (size_t)((((dbase >> 4) + dt) * 2 + s2) * 64 + lane) * 8); \
    } while (0)
#define SCAN_LOAD(c_, rqe, rks, rvt, rin, rdec) do { \
        _Pragma("unroll") for (int k = 0; k < NU; ++k) { const int u = tid + 512 * k; \
            rqe[k] = *(const u32x4*)(QEg + (size_t)(c_) * 64 * DK + (size_t)u * 8); } \
          \
        if (tid < 256) rvt = *(const u32x4*)(VTTg + (size_t)(c_) * DV * 64 + (size_t)tid * 8); \
        rin = *(const u32x2*)(inb + (size_t)(c_) * (DV / 16) * 2048 + inl); \
        if (HG) { _Pragma("unroll") for (int dt = 0; dt < DT; ++dt) rdec[dt] = *(const f32x4*)(DECg + (size_t)(c_) * 128 + dbase + 16 * dt + 4 * g); } \
    } while (0)
#define SCAN_STEP(c_, rqe, rks, rvt, rin, rdec) do { \
          \
        _Pragma("unroll") for (int k = 0; k < NU; ++k) { const int u = tid + 512 * k; const int i = u / (DK / 8), cc = u % (DK / 8); \
            *(LAS u32x4*)(Qe + i * LQ + 8 * cc) = rqe[k]; } \
        if (tid < 256) *(LAS u32x4*)(VT + (tid >> 3) * LT + 8 * (tid & 7)) = rvt; \
        _Pragma("unroll") for (int dt = 0; dt < DT; ++dt) \
            _Pragma("unroll") for (int et = 0; et < 2; ++et) { u32x2 w; w.x = pk2(st[dt][et][0], st[dt][et][1]); w.y = pk2(st[dt][et][2], st[dt][et][3]); \
                *(LAS u32x2*)(STb + (16 * et + r) * LQ + dbase + 16 * dt + 4 * g) = w; } \
        const u32x2 inx = rin; f32x4 dec[DT]; \
        _Pragma("unroll") for (int dt = 0; dt < DT; ++dt) dec[dt] = HG ? rdec[dt] : (f32x4){0.f, 0.f, 0.f, 0.f}; \
        LDS_BAR(); \
        if ((c_) + 4 < 64) SCAN_LOAD((c_) + 4, rqe, rks, rvt, rin, rdec); \
          \
        const f32x4 accc = mma_tile(STb + 16 * te * LQ, LQ, Qe + 16 * ti * LQ, LQ, KS, (f32x4){0.f, 0.f, 0.f, 0.f}, r, g); \
        { const float xi = HG ? 1.0f : TAB[16 * ti + r + 1]; \
          u32x2 w; w.x = pk2(bflo(inx.x) + xi * accc[0], bfhi(inx.x) + xi * accc[1]); w.y = pk2(bflo(inx.y) + xi * accc[2], bfhi(inx.y) + xi * accc[3]); \
          *(u32x2*)(outp + (size_t)(c_) * 64 * 1024) = w; } \
          \
        const float g64 = HG ? 1.0f : TAB[64]; \
        { bf16x8 vfr[2][2]; \
          _Pragma("unroll") for (int et = 0; et < 2; ++et) _Pragma("unroll") for (int s2 = 0; s2 < 2; ++s2) vfr[et][s2] = *(const LAS bf16x8*)(VT + (16 * et + r) * LT + 8 * g + 32 * s2); \
          _Pragma("unroll") for (int dt = 0; dt < DT; ++dt) \
            _Pragma("unroll") for (int et = 0; et < 2; ++et) { \
                const f32x4 dd = HG ? dec[dt] : (f32x4){g64, g64, g64, g64}; f32x4 acc = st[dt][et] * dd; \
                _Pragma("unroll") for (int s2 = 0; s2 < 2; ++s2) acc = __builtin_amdgcn_mfma_f32_16x16x32_bf16(__builtin_bit_cast(bf16x8, rks[2 * dt + s2]), vfr[et][s2], acc, 0, 0, 0); \
                st[dt][et] = acc; } } \
        if ((c_) + 4 < 64) SCAN_LOAD_K((c_) + 4, rks);        \
        LDS_BAR(); \
    } while (0)
    SCAN_LOAD(0, rqeA, rksA, rvtA, rinA, rdecA);
    SCAN_LOAD_K(0, rksA);
    SCAN_LOAD(1, rqeB, rksB, rvtB, rinB, rdecB);
    SCAN_LOAD_K(1, rksB);
    SCAN_LOAD(2, rqeC, rksC, rvtC, rinC, rdecC);
    SCAN_LOAD_K(2, rksC);
    SCAN_LOAD(3, rqeD, rksD, rvtD, rinD, rdecD);
    SCAN_LOAD_K(3, rksD);
    __syncthreads();
    for (int c = 0; c < 64; c += 4) {
        SCAN_STEP(c, rqeA, rksA, rvtA, rinA, rdecA);
        SCAN_STEP(c + 1, rqeB, rksB, rvtB, rinB, rdecB);
        SCAN_STEP(c + 2, rqeC, rksC, rvtC, rinC, rdecC);
        SCAN_STEP(c + 3, rqeD, rksD, rvtD, rinD, rdecD);
    }
#undef SCAN_STEP
#undef SCAN_LOAD
#undef SCAN_LOAD_K
    __syncthreads();
}

__device__ __forceinline__ void sgu_stats_rows(const Args& a, int gw, int NGW, int lane) {
    asm volatile("" : "+v"(lane));
    const bf16* Z = (const bf16*)(a.ws + WS_Z); float* SG = (float*)(a.ws + WS_SGST);
    for (int m0 = gw; m0 < M; m0 += 4 * NGW) {
        u32x4 p0[4], p1[4];
#pragma unroll
        for (int q = 0; q < 4; ++q) { const int m = (m0 + q * NGW < M) ? m0 + q * NGW : m0; const bf16* zr = Z + (size_t)m * EVEN_IN + 5120;
            p0[q] = *(const u32x4*)(zr + lane * 8); p1[q] = *(const u32x4*)(zr + 512 + lane * 8); }
#pragma unroll
        for (int q = 0; q < 4; ++q) { const int m = m0 + q * NGW; if (m >= M) break;
            float x[16];
#pragma unroll
            for (int e = 0; e < 4; ++e) { x[2 * e] = bflo(p0[q][e]); x[2 * e + 1] = bfhi(p0[q][e]); x[8 + 2 * e] = bflo(p1[q][e]); x[8 + 2 * e + 1] = bfhi(p1[q][e]); }
            float s = 0.f;
#pragma unroll
            for (int e = 0; e < 16; ++e) s += x[e];
            const float mean = wave_sum(s) * (1.0f / 1024.0f); float qq = 0.f;
#pragma unroll
            for (int e = 0; e < 16; ++e) { const float dd = x[e] - mean; qq += dd * dd; }
            const float var = wave_sum(qq) * (1.0f / 1024.0f);
            if (lane == 0) { SG[2 * m] = mean; SG[2 * m + 1] = __builtin_amdgcn_rsqf(var + EPS); } }
    }
}
__device__ __forceinline__ void sgu_item(const Args& a, LAS unsigned char* lds, int item, int tid, int lane, int wave) {
    constexpr int LW = 136;
    constexpr int O_W = 0, O_V = O_W + 128 * LW * 2, O_ST = O_V + 256 * LW * 2;
    LAS bf16* Wm = (LAS bf16*)(lds + O_W); LAS bf16* VnT = (LAS bf16*)(lds + O_V); LAS float* ST = (LAS float*)(lds + O_ST);
    const int win = item >> 2, grp = item & 3, r = lane & 15, g = lane >> 4;
    const bf16* Z = (const bf16*)(a.ws + WS_Z); bf16* MIX0 = (bf16*)(a.ws + WS_MIX0);
    const size_t tok0 = (size_t)win * 128;
    { const float* ws_ = a.in[I_SGU_WS] + (size_t)grp * 128 * 128;
      for (int u = tid; u < 128 * 16; u += 512) { const int i = u >> 4, j0 = (u & 15) * 8;
          const f32x4 w0 = *(const f32x4*)(ws_ + i * 128 + j0), w1 = *(const f32x4*)(ws_ + i * 128 + j0 + 4);
          const bool ok = (j0 >> 6) <= (i >> 6);
          u32x4 o; o.x = ok ? pk2(w0.x, w0.y) : 0u; o.y = ok ? pk2(w0.z, w0.w) : 0u; o.z = ok ? pk2(w1.x, w1.y) : 0u; o.w = ok ? pk2(w1.z, w1.w) : 0u;
          *(LAS u32x4*)(Wm + i * LW + j0) = o; } }
    if (tid < 64) { const f32x4 sv = *(const f32x4*)((const float*)(a.ws + WS_SGST) + 2 * tok0 + 4 * tid); *(LAS f32x4*)(ST + 4 * tid) = sv; }
    __syncthreads();
    { const float* lng = a.in[I_SGU_LNG] + 256 * grp; const float* lnb = a.in[I_SGU_LNB] + 256 * grp;
      u32x4 pv[8];
#pragma unroll
      for (int k = 0; k < 8; ++k) { const int u = tid + 512 * k; const int j = u & 127, c0 = (u >> 7) * 8; pv[k] = *(const u32x4*)(Z + (tok0 + j) * EVEN_IN + 5120 + 256 * grp + c0); }
      __builtin_amdgcn_sched_barrier(0);
#pragma unroll
      for (int k = 0; k < 8; ++k) { const int u = tid + 512 * k; const int j = u & 127, c0 = (u >> 7) * 8; const u32x4 p = pv[k];
          const float mean = ST[2 * j], rstd = ST[2 * j + 1];
#pragma unroll
          for (int e = 0; e < 4; ++e) { const float x0 = (bflo(p[e]) - mean) * rstd * lng[c0 + 2 * e] + lnb[c0 + 2 * e], x1 = (bfhi(p[e]) - mean) * rstd * lng[c0 + 2 * e + 1] + lnb[c0 + 2 * e + 1];
              VnT[(c0 + 2 * e) * LW + j] = f2bf1(x0); VnT[(c0 + 2 * e + 1) * LW + j] = f2bf1(x1); } } }
    u32x2 upv[2][8];
#pragma unroll
    for (int q = 0; q < 2; ++q)
#pragma unroll
        for (int it = 0; it < 8; ++it) upv[q][it] = *(const u32x2*)(Z + (tok0 + 16 * it + r) * EVEN_IN + 4096 + 256 * grp + 16 * (2 * wave + q) + 4 * g);
    __syncthreads();
    const float* bs = a.in[I_SGU_BS] + 128 * grp;
#pragma unroll
    for (int q = 0; q < 2; ++q)
#pragma unroll
        for (int it = 0; it < 8; ++it) { const int ct = 2 * wave + q;
            const f32x4 acc = mma_tile(VnT + 16 * ct * LW, LW, Wm + 16 * it * LW, LW, 4, (f32x4){0.f, 0.f, 0.f, 0.f}, r, g);
            const int i = 16 * it + r, c = 16 * ct + 4 * g; const float bias = bs[i];
            const u32x2 up = upv[q][it];
            u32x2 w; w.x = pk2(bflo(up.x) * (acc[0] + bias), bfhi(up.x) * (acc[1] + bias)); w.y = pk2(bflo(up.y) * (acc[2] + bias), bfhi(up.y) * (acc[3] + bias));
            *(u32x2*)(MIX0 + (tok0 + i) * DM + 1024 + 256 * grp + c) = w; }
    __syncthreads();
}

template <bool HG>
__device__ __forceinline__ void postnorm_rows(const Args& a, int gw, int NGW, int lane) {
    asm volatile("" : "+v"(lane));
    const bf16* RAW = (const bf16*)(a.ws + WS_RAW); const bf16* Z = (const bf16*)(a.ws + WS_Z);
    bf16* O = (bf16*)(a.ws + (HG ? WS_MIX1 : WS_MIX0)); const int ldo = DM, ldz = HG ? ODD_PAD : EVEN_IN;
    f32x4 ng[4];
    if (HG) {
#pragma unroll
        for (int e = 0; e < 4; ++e) ng[e] = *(const f32x4*)(a.in[I_HG_NG] + 16 * lane + 4 * e); }
    for (int m0 = gw; m0 < M; m0 += 4 * NGW) {
        u32x4 p0[4], p1[4], g0[4], g1[4];
#pragma unroll
        for (int q = 0; q < 4; ++q) { const int m = (m0 + q * NGW < M) ? m0 + q * NGW : m0;
            const bf16* rr = RAW + (size_t)m * 1024 + 16 * lane; const bf16* gr = Z + (size_t)m * ldz + 3072 + 16 * lane;
            p0[q] = *(const u32x4*)rr; p1[q] = *(const u32x4*)(rr + 8); g0[q] = *(const u32x4*)gr; g1[q] = *(const u32x4*)(gr + 8); }
#pragma unroll
        for (int q = 0; q < 4; ++q) { const int m = m0 + q * NGW; if (m >= M) break;
            float x[16], gt[16];
#pragma unroll
            for (int e = 0; e < 4; ++e) { x[2 * e] = bflo(p0[q][e]); x[2 * e + 1] = bfhi(p0[q][e]); x[8 + 2 * e] = bflo(p1[q][e]); x[8 + 2 * e + 1] = bfhi(p1[q][e]);
                gt[2 * e] = bflo(g0[q][e]); gt[2 * e + 1] = bfhi(g0[q][e]); gt[8 + 2 * e] = bflo(g1[q][e]); gt[8 + 2 * e + 1] = bfhi(g1[q][e]); }
            float s = 0.f;
#pragma unroll
            for (int e = 0; e < 16; ++e) s += x[e] * x[e];
            s = HG ? row_sum8(s) : row_sum16(s);
            const float rstd = __builtin_amdgcn_rsqf(s * (HG ? (1.0f / 128.0f) : (1.0f / 256.0f)) + EPS);
            float y[16];
#pragma unroll
            for (int e = 0; e < 16; ++e) { float v = x[e] * rstd; if (HG) v *= ng[e >> 2][e & 3]; y[e] = v * (gt[e] * __builtin_amdgcn_rcpf(1.0f + __expf(-gt[e]))); }
            u32x4 o0, o1; o0.x = pk2(y[0], y[1]); o0.y = pk2(y[2], y[3]); o0.z = pk2(y[4], y[5]); o0.w = pk2(y[6], y[7]); o1.x = pk2(y[8], y[9]); o1.y = pk2(y[10], y[11]); o1.z = pk2(y[12], y[13]); o1.w = pk2(y[14], y[15]);
            bf16* op = O + (size_t)m * ldo + 16 * lane; *(u32x4*)op = o0; *(u32x4*)(op + 8) = o1; }
    }
}
__device__ __forceinline__ void kvn_rows(const Args& a, int gw, int NGW, int lane) {
    asm volatile("" : "+v"(lane));
    const bf16* Z = (const bf16*)(a.ws + WS_Z); bf16* KVN = (bf16*)(a.ws + WS_KVN);
    const f32x4 gg = *(const f32x4*)(a.in[I_CKV_G] + 4 * lane);
    for (int m0 = gw; m0 < M; m0 += 4 * NGW) {
        u32x2 p[4]; unsigned short cqv[4][6]; u32x4 kx[4];
#pragma unroll
        for (int q = 0; q < 4; ++q) { const int m = (m0 + q * NGW < M) ? m0 + q * NGW : m0;
            p[q] = *(const u32x2*)(Z + (size_t)m * ODD_PAD + Z1_CKV + 4 * lane);
            kx[q] = *(const u32x4*)(Z + (size_t)m * ODD_PAD + Z1_KIDX + 8 * (lane & 7));
            const unsigned short* cr = (const unsigned short*)(Z + (size_t)m * ODD_PAD + Z1_CQ);
#pragma unroll
            for (int e = 0; e < 6; ++e) cqv[q][e] = cr[lane + 64 * e]; }
#pragma unroll
        for (int q = 0; q < 4; ++q) { const int m = m0 + q * NGW; if (m >= M) break;
            const float x0 = bflo(p[q].x), x1 = bfhi(p[q].x), x2 = bflo(p[q].y), x3 = bfhi(p[q].y);
            const float rstd = __builtin_amdgcn_rsqf(wave_sum(x0 * x0 + x1 * x1 + x2 * x2 + x3 * x3) * (1.0f / 256.0f) + EPS);
            u32x2 w; w.x = pk2(x0 * rstd * gg.x, x1 * rstd * gg.y); w.y = pk2(x2 * rstd * gg.z, x3 * rstd * gg.w);
            *(u32x2*)(KVN + (size_t)m * 256 + 4 * lane) = w;
            if (lane < 8) *(u32x4*)((bf16*)(a.ws + WS_KIDXF) + ((size_t)((m >> 5) * 4 + (lane >> 1)) * 64 + 32 * (lane & 1) + (m & 31)) * 8) = kx[q];
            { float s = 0.f;
#pragma unroll
              for (int e = 0; e < 6; ++e) { const float x = __builtin_bit_cast(float, (unsigned)cqv[q][e] << 16); s += x * x; }
              s = wave_sum(s) * (1.0f / 384.0f); if (lane == 0) ((float*)(a.ws + WS_MSCQ))[m] = s; } }
    }
}

__device__ __forceinline__ unsigned f2key(float f) { const unsigned u = __float_as_uint(f); return u ^ ((u >> 31) ? 0xffffffffu : 0x80000000u); }


__device__ __forceinline__ int wave_sum_i(int v) {
    v += __builtin_amdgcn_update_dpp(0, v, 0xB1, 0xF, 0xF, true); v += __builtin_amdgcn_update_dpp(0, v, 0x4E, 0xF, 0xF, true);
    v += __builtin_amdgcn_update_dpp(0, v, 0x141, 0xF, 0xF, true); v += __builtin_amdgcn_update_dpp(0, v, 0x140, 0xF, 0xF, true);
    return (__builtin_amdgcn_readlane(v, 0) + __builtin_amdgcn_readlane(v, 16)) + (__builtin_amdgcn_readlane(v, 32) + __builtin_amdgcn_readlane(v, 48));
}
__device__ __forceinline__ void transpose32(unsigned (&A)[32]) {
    unsigned m = 0x0000FFFFu;
#pragma unroll
    for (int j = 16; j != 0; j >>= 1) {
#pragma unroll
        for (int k0 = 0; k0 < 32; ++k0) { if (k0 & j) continue; const unsigned t = (A[k0] ^ (A[k0 + j] >> j)) & m; A[k0] ^= t; A[k0 + j] ^= (t << j); }
        m ^= (m << (j >> 1));
    }
}
template <int NB>
__device__ __forceinline__ void select_top256(const LAS float* sq, int nk, unsigned short* so, int lane) {
    unsigned P[NB][32], C[NB], G[NB];
    const int nreg = nk >> 6;
#pragma unroll
    for (int b = 0; b < NB; ++b) {
#pragma unroll
        for (int k = 0; k < 32; ++k) { const int i = 32 * b + k; P[b][k] = (i < nreg) ? f2key(sq[64 * i + lane]) : 0u; }
        const int nv = nreg - 32 * b; C[b] = (nv <= 0) ? 0u : (nv >= 32 ? 0xFFFFFFFFu : (0xFFFFFFFFu << (32 - nv))); G[b] = 0u;
        transpose32(P[b]);
    }
    bool done = false;
#pragma unroll
    for (int p = 0; p < 32; ++p) {
        if (!done) {
            int c = 0; unsigned x[NB];
#pragma unroll
            for (int b = 0; b < NB; ++b) { x[b] = C[b] & P[b][p]; c += __popc(G[b] | x[b]); }
            const int cnt = wave_sum_i(c);
            if (cnt >= 256) {
#pragma unroll
                for (int b = 0; b < NB; ++b) C[b] = x[b];
                if (cnt == 256) { done = true;
#pragma unroll
                    for (int b = 0; b < NB; ++b) { G[b] |= C[b]; C[b] = 0u; } }
            } else {
#pragma unroll
                for (int b = 0; b < NB; ++b) { G[b] |= x[b]; C[b] &= ~P[b][p]; }
            }
        }
    }
    if (!done) {
        int cg = 0, cc = 0;
#pragma unroll
        for (int b = 0; b < NB; ++b) { cg += __popc(G[b]); cc += __popc(C[b]); }
        int need = 256 - wave_sum_i(cg); const int nc = wave_sum_i(cc);
        if (nc == need) {
#pragma unroll
            for (int b = 0; b < NB; ++b) G[b] |= C[b];
        } else {
            const unsigned long long lt_mask = (lane == 0) ? 0ull : (~0ull >> (64 - lane));
            for (int i = 0; i < nreg && need > 0; ++i) { const unsigned cb = (NB > 1 && i >= 32) ? C[NB - 1] : C[0]; const unsigned bit = 1u << (31 - (i & 31));
                const bool eq = (cb & bit) != 0u; const unsigned long long meq = __ballot(eq);
                if (eq && __popcll(meq & lt_mask) < need) { if (NB > 1 && i >= 32) G[NB - 1] |= bit; else G[0] |= bit; }
                need -= __popcll(meq); }
        }
    }
    int n = 0;
#pragma unroll
    for (int b = 0; b < NB; ++b) n += __popc(G[b]);
    int inc = n;
#pragma unroll
    for (int d = 1; d < 64; d <<= 1) { const int t = __shfl_up(inc, d); if (lane >= d) inc += t; }
    int pos = inc - n;
#pragma unroll
    for (int b = 0; b < NB; ++b) { unsigned m = G[b];
        while (m) { const int beta = __builtin_ctz(m); const int k = 31 - beta; if (pos < 256) so[pos] = (unsigned short)(64 * (32 * b + k) + lane); ++pos; m &= m - 1u; } }
}

__device__ __forceinline__ void idx_group(const Args& a, LAS unsigned char* lds, int grp, int tid, int lane, int wave) {
    LAS float* sc = (LAS float*)lds;
    const bf16* Z = (const bf16*)(a.ws + WS_Z); const bf16* QI = (const bf16*)(a.ws + WS_QI);
    unsigned short* SEL = (unsigned short*)(a.ws + WS_SEL); int* NSEL = (int*)(a.ws + WS_NSEL);
    const int m0 = grp * 8, b = m0 >> 12, t0 = m0 & 4095, cq = t0 >> 6, nk = 64 * (cq + 1);
    const size_t kb0 = (size_t)b * SEQ;
    if (nk <= 256) {
        for (int u = tid; u < 8 * 256; u += 512) { const int q = u >> 8, s = u & 255; SEL[(size_t)(m0 + q) * 256 + s] = (unsigned short)(s < nk ? s : 0); }
        if (tid < 8) NSEL[m0 + tid] = nk;
        return;
    }
    const int r = lane & 31, hh = lane >> 5;
    const int qsel = (r >> 2) & 1, head = (r & 3) + 4 * (r >> 3);
    bf16x8 af[4][4]; float wv[4][16];
#pragma unroll
    for (int p = 0; p < 4; ++p) { const bf16* qrow = QI + (size_t)(m0 + 2 * p + qsel) * 1024 + head * 64 + 8 * hh;
#pragma unroll
        for (int s = 0; s < 4; ++s) af[p][s] = *(const bf16x8*)(qrow + 16 * s);
        const bf16* wrow = Z + (size_t)(m0 + 2 * p + hh) * ODD_PAD + Z1_WIDX;
        const u32x4 w0 = *(const u32x4*)wrow, w1 = *(const u32x4*)(wrow + 8);
#pragma unroll
        for (int e = 0; e < 4; ++e) { wv[p][2 * e] = bflo(w0[e]); wv[p][2 * e + 1] = bfhi(w0[e]); wv[p][8 + 2 * e] = bflo(w1[e]); wv[p][8 + 2 * e + 1] = bfhi(w1[e]); } }
    const int nkt = nk >> 5;
    bf16x8 bnx[4];
    const bf16* KF = (const bf16*)(a.ws + WS_KIDXF) + (size_t)(kb0 >> 5) * 4 * 64 * 8 + (size_t)lane * 8;
    {
#pragma unroll
      for (int s = 0; s < 4; ++s) bnx[s] = *(const bf16x8*)(KF + (size_t)(wave * 4 + s) * 512); }
    for (int kt = wave; kt < nkt; kt += 8) {
        bf16x8 bfr[4];
#pragma unroll
        for (int s = 0; s < 4; ++s) bfr[s] = bnx[s];
        { const int ktn = (kt + 8 < nkt) ? kt + 8 : kt;
#pragma unroll
          for (int s = 0; s < 4; ++s) bnx[s] = *(const bf16x8*)(KF + (size_t)(ktn * 4 + s) * 512); }
        __builtin_amdgcn_sched_barrier(0);
#pragma unroll
        for (int p = 0; p < 4; ++p) {
            f32x16 acc;
#pragma unroll
            for (int e = 0; e < 16; ++e) acc[e] = 0.f;
#pragma unroll
            for (int s = 0; s < 4; ++s) acc = __builtin_amdgcn_mfma_f32_32x32x16_bf16(af[p][s], bfr[s], acc, 0, 0, 0);
            float v = 0.f;
#pragma unroll
            for (int e = 0; e < 16; ++e) v += wv[p][e] * fmaxf(acc[e], 0.f);
            sc[(2 * p + hh) * 4096 + 32 * kt + r] = v;
        }
    }
    __syncthreads();
    { unsigned short* so = SEL + (size_t)(m0 + wave) * 256; const LAS float* sq = sc + wave * 4096;
      if (nk <= 2048) select_top256<1>(sq, nk, so, lane); else select_top256<2>(sq, nk, so, lane);
      if (lane == 0) NSEL[m0 + wave] = 256; }
    __syncthreads();
}

__device__ __forceinline__ int rel_bucket(int rel) {
    const int ret = rel > 0 ? 16 : 0; const int n = rel < 0 ? -rel : rel;
    if (n < 8) return ret + n;
    int large = 8 + (int)(logf((float)n / 8.0f) / 3.4657359027997265f * 8.0f);
    large = large < 15 ? large : 15;
    return ret + large;
}
__device__ __forceinline__ unsigned kv_fx(unsigned row) { return ((row & 3u) << 1) | ((((row >> 2) ^ (row >> 3)) & 1u) << 3) | ((row >> 3) & 1u); }
__device__ __forceinline__ unsigned kv_off(unsigned row, unsigned ch) { return 512u * row + 16u * (ch ^ kv_fx(row)); }
typedef short s16x4 __attribute__((ext_vector_type(4)));
#ifndef PVB
#define PVB 4
#endif
__device__ __forceinline__ void attn_queries(const Args& a, LAS unsigned char* lds, int q_begin, int q_end, int tid, int lane, int wave) {
    asm volatile("" : "+v"(lane)); asm volatile("" : "+v"(tid));
    constexpr int WREG = 20160, O_PW = 16384, O_ZW = 16384 + 640, O_SW = 16384 + 640 + 64, O_QW = 16384 + 640 + 64 + 512, O_BK = O_QW + 2304, LQW = 144, LP = 40, O_BIAS = 8 * WREG;
    static_assert(O_BK + 256 <= WREG, "attention LDS map (wave region)");
    static_assert(O_BIAS + 2048 <= LDS_BYTES - 128, "attention LDS map");
    LAS unsigned char* KVc = lds + wave * WREG; LAS bf16* Pw = (LAS bf16*)(KVc + O_PW); LAS float* Zw = (LAS float*)(KVc + O_ZW); LAS unsigned short* SELw = (LAS unsigned short*)(KVc + O_SW); LAS bf16* Qw = (LAS bf16*)(KVc + O_QW); LAS unsigned char* BKw = KVc + O_BK; LAS float* BIAS = (LAS float*)(lds + O_BIAS); LAS float* GQ = BIAS + 256;
    const bf16* QRAW = (const bf16*)(a.ws + WS_QRAW); const bf16* KVN = (const bf16*)(a.ws + WS_KVN);
    const unsigned short* SEL = (const unsigned short*)(a.ws + WS_SEL); const int* NSEL = (const int*)(a.ws + WS_NSEL); const float* MSCQ = (const float*)(a.ws + WS_MSCQ);
    bf16* OBUF = (bf16*)(a.ws + WS_OBUF);
    const int r = lane & 15, g = lane >> 4, part = lane & 31, sub = lane >> 5, hq = r & 7;
    const unsigned q4 = (unsigned)(lane & 15) >> 2, p4 = (unsigned)lane & 3u, sh16 = 16u * (unsigned)sub, part16 = 16u * (unsigned)part;
    if (tid < 256) { BIAS[tid] = (a.in[I_RELB][tid] - 8.0f) * 1.4426950408889634f; GQ[tid] = a.in[I_QN_G][tid]; }
    __syncthreads();
    for (int m = q_begin + wave; m < q_end; m += 8) {
        const int t = m & 4095; const char* kvb = (const char*)KVN + (size_t)(m >> 12) * SEQ * 512;
        const int nch = __builtin_amdgcn_readfirstlane(NSEL[m]) >> 5;
        const unsigned short* selm = SEL + (size_t)m * 256;
        u32x4 raw[8];
        const u32x2 sv = *(const u32x2*)((const char*)SEL + ((unsigned)m * 512u + 8u * (unsigned)lane));
#pragma unroll
        for (int s = 0; s < 8; ++s) raw[s] = *(const u32x4*)((const char*)QRAW + ((unsigned)m * 4096u + (unsigned)(512 * hq + 64 * s + 16 * g)));
        const float mscq = MSCQ[m];
        __builtin_amdgcn_sched_barrier(0);
        { *(LAS u32x2*)(SELw + 4 * lane) = sv;
          const unsigned bk = (unsigned)rel_bucket((int)(sv.x & 0xffffu) - t) | ((unsigned)rel_bucket((int)(sv.x >> 16) - t) << 8) | ((unsigned)rel_bucket((int)(sv.y & 0xffffu) - t) << 16) | ((unsigned)rel_bucket((int)(sv.y >> 16) - t) << 24);
          *(LAS unsigned*)(BKw + 4 * lane) = bk; }
        asm volatile("" ::: "memory");
        bf16x8 qf[8];
        { float ss = 0.f;
#pragma unroll
          for (int s = 0; s < 8; ++s) {
#pragma unroll
              for (int e = 0; e < 4; ++e) { const float x0 = bflo(raw[s][e]), x1 = bfhi(raw[s][e]); ss += x0 * x0 + x1 * x1; } }
          ss += __shfl_xor(ss, 16); ss += __shfl_xor(ss, 32);
          const float rstd = __builtin_amdgcn_rsqf(ss * (1.0f / 256.0f) + EPS * (mscq + EPS));
#pragma unroll
          for (int s = 0; s < 8; ++s) { const f32x4 g0 = *(const LAS f32x4*)(GQ + 32 * s + 8 * g), g1 = *(const LAS f32x4*)(GQ + 32 * s + 8 * g + 4);
              u32x4 w; w.x = pk2(bflo(raw[s].x) * rstd * g0.x, bfhi(raw[s].x) * rstd * g0.y); w.y = pk2(bflo(raw[s].y) * rstd * g0.z, bfhi(raw[s].y) * rstd * g0.w);
              w.z = pk2(bflo(raw[s].z) * rstd * g1.x, bfhi(raw[s].z) * rstd * g1.y); w.w = pk2(bflo(raw[s].w) * rstd * g1.z, bfhi(raw[s].w) * rstd * g1.w);
              qf[s] = __builtin_bit_cast(bf16x8, w); } }
        if (r < 8) {
#pragma unroll
            for (int s = 4; s < 8; ++s) *(LAS bf16x8*)(Qw + hq * LQW + 32 * (s - 4) + 8 * g) = qf[s]; }
        asm volatile("" ::: "memory");
        u32x4 pre[16];
        { u32x4 iw[4];
#pragma unroll
          for (int k = 0; k < 4; ++k) iw[k] = *(const LAS u32x4*)(SELw + 8 * k);
#pragma unroll
          for (int i = 0; i < 16; ++i) { const unsigned idx = __builtin_amdgcn_ubfe(iw[i >> 2][i & 3], sh16, 16u); pre[i] = *(const u32x4*)(kvb + ((idx << 9) | part16)); } }
        f32x4 o[16]; f32x4 zs = (f32x4){0.f, 0.f, 0.f, 0.f};
#pragma unroll
        for (int c2 = 0; c2 < 16; ++c2) o[c2] = (f32x4){0.f, 0.f, 0.f, 0.f};
        const unsigned fxr = kv_fx((unsigned)r);
        for (int c = 0; c < nch; ++c) {
#pragma unroll
            for (int i = 0; i < 16; ++i) *(LAS u32x4*)(KVc + kv_off((unsigned)(2 * i + sub), (unsigned)part)) = pre[i];
            const int b0 = (int)BKw[32 * c + r], b1 = (int)BKw[32 * c + 16 + r];
            asm volatile("" ::: "memory");
            if (c + 1 < nch) { u32x4 iw[4];
#pragma unroll
                for (int k = 0; k < 4; ++k) iw[k] = *(const LAS u32x4*)(SELw + 32 * (c + 1) + 8 * k);
#pragma unroll
                for (int i = 0; i < 16; ++i) { const unsigned idx = __builtin_amdgcn_ubfe(iw[i >> 2][i & 3], sh16, 16u); pre[i] = *(const u32x4*)(kvb + ((idx << 9) | part16)); } }
            f32x4 acc0 = (f32x4){0.f, 0.f, 0.f, 0.f}, acc1 = (f32x4){0.f, 0.f, 0.f, 0.f};
            { const LAS unsigned char* rowp0 = KVc + 512 * r; const LAS unsigned char* rowp1 = rowp0 + 512 * 16;
#pragma unroll
              for (int s = 0; s < 8; ++s) { const unsigned so = 16u * ((unsigned)(4 * s + g) ^ fxr);
                  const bf16x8 k0 = *(const LAS bf16x8*)(rowp0 + so), k1 = *(const LAS bf16x8*)(rowp1 + so);
                  const bf16x8 qs = (s < 4) ? qf[s] : *(const LAS bf16x8*)(Qw + hq * LQW + 32 * (s - 4) + 8 * g);
                  acc0 = __builtin_amdgcn_mfma_f32_16x16x32_bf16(qs, k0, acc0, 0, 0, 0); acc1 = __builtin_amdgcn_mfma_f32_16x16x32_bf16(qs, k1, acc1, 0, 0, 0); } }
            { const int gg = g & 1;
              const f32x4 bb0 = *(const LAS f32x4*)(BIAS + b0 * 8 + 4 * gg), bb1 = *(const LAS f32x4*)(BIAS + b1 * 8 + 4 * gg);
              f32x4 p0, p1;
#pragma unroll
              for (int jj = 0; jj < 4; ++jj) { p0[jj] = __builtin_amdgcn_exp2f(__builtin_fmaf(acc0[jj], 0.0625f * 1.4426950408889634f, bb0[jj])); p1[jj] = __builtin_amdgcn_exp2f(__builtin_fmaf(acc1[jj], 0.0625f * 1.4426950408889634f, bb1[jj])); }
              zs += p0 + p1;
              if (g < 2) {
#pragma unroll
                  for (int jj = 0; jj < 4; ++jj) { Pw[(4 * g + jj) * LP + r] = f2bf1(p0[jj]); Pw[(4 * g + jj) * LP + 16 + r] = f2bf1(p1[jj]); } } }
            asm volatile("" ::: "memory");
            { const bf16x8 pf = *(const LAS bf16x8*)(Pw + hq * LP + 8 * g);
              LAS unsigned char* kvp = KVc; asm volatile("" : "+v"(kvp));
              const unsigned row0 = 8u * g + q4, row1 = row0 + 4u;
#pragma unroll
              for (int cb = 0; cb < 8; cb += 2) { s16x4 a0[4], a1[4];
#pragma unroll
                  for (int q = 0; q < 2; ++q) { const unsigned ch = 2u * (cb + q) + (p4 >> 1);
                      LAS unsigned char* p0a = kvp + kv_off(row0, ch) + 8u * (p4 & 1u); LAS unsigned char* p1a = kvp + kv_off(row1, ch) + 8u * (p4 & 1u);
                      a0[q] = __builtin_amdgcn_ds_read_tr16_b64_v4i16((LAS s16x4*)p0a); a1[q] = __builtin_amdgcn_ds_read_tr16_b64_v4i16((LAS s16x4*)p1a);
                      a0[2 + q] = __builtin_amdgcn_ds_read_tr16_b64_v4i16((LAS s16x4*)(p0a + 256)); a1[2 + q] = __builtin_amdgcn_ds_read_tr16_b64_v4i16((LAS s16x4*)(p1a + 256)); }
                  __builtin_amdgcn_sched_barrier(0);
#pragma unroll
                  for (int q = 0; q < 4; ++q) { const int c2 = cb + (q & 1) + 8 * (q >> 1); const bf16x8 af = {a0[q][0], a0[q][1], a0[q][2], a0[q][3], a1[q][0], a1[q][1], a1[q][2], a1[q][3]};
                      o[c2] = __builtin_amdgcn_mfma_f32_16x16x32_bf16(af, pf, o[c2], 0, 0, 0); }
                  __builtin_amdgcn_sched_barrier(0); } }
            asm volatile("" ::: "memory");
        }
        { const float z0 = row_sum16(zs[0]), z1 = row_sum16(zs[1]), z2 = row_sum16(zs[2]), z3 = row_sum16(zs[3]);
          if (g < 2 && r == 0) { Zw[4 * g] = z0; Zw[4 * g + 1] = z1; Zw[4 * g + 2] = z2; Zw[4 * g + 3] = z3; }
          asm volatile("" ::: "memory");
          const float iz = 1.0f / Zw[hq];
          unsigned l2 = (unsigned)lane; asm volatile("" : "+v"(l2));
          LAS unsigned char* ob = KVc;
          if (r < 8) { LAS unsigned char* op = ob + 544u * (l2 & 15u) + 8u * (l2 >> 4);
#pragma unroll
              for (int c2 = 0; c2 < 16; ++c2) { u32x2 w; w.x = pk2(o[c2][0] * iz, o[c2][1] * iz); w.y = pk2(o[c2][2] * iz, o[c2][3] * iz); *(LAS u32x2*)(op + 32 * c2) = w; } }
          asm volatile("" ::: "memory");
#pragma unroll
          for (int i = 0; i < 4; ++i) { const unsigned ci = l2 + 64u * i; const u32x4 w = *(const LAS u32x4*)(ob + 544u * (ci >> 5) + 16u * (ci & 31u));
              *(u32x4*)((char*)OBUF + ((unsigned)m * 4096u + 16u * ci)) = w; }
          asm volatile("" ::: "memory"); }
    }
    __syncthreads();
}

__device__ __forceinline__ void uv_project_pair(const Args& a, int mt0, int h, int lane) {
    asm volatile("" : "+v"(lane));
    const bf16* OBUF = (const bf16*)(a.ws + WS_OBUF); const bf16* WUVT = (const bf16*)(a.ws + WS_WUVT); bf16* MIX1 = (bf16*)(a.ws + WS_MIX1);
    const int r = lane & 15, g = lane >> 4;
    bf16x8 of[2][8];
#pragma unroll
    for (int t = 0; t < 2; ++t)
#pragma unroll
        for (int s = 0; s < 8; ++s) of[t][s] = *(const bf16x8*)(OBUF + (size_t)(16 * (mt0 + t) + r) * 2048 + 256 * h + 32 * s + 8 * g);
#pragma unroll 1
    for (int np = 0; np < 4; ++np) { bf16x8 wf[2][8];
#pragma unroll
        for (int q = 0; q < 2; ++q) { const bf16* wr = WUVT + ((size_t)((h * 8 + 2 * np + q) * 8) * 64 + lane) * 8;
#pragma unroll
            for (int s = 0; s < 8; ++s) wf[q][s] = *(const bf16x8*)(wr + 512 * s); }
        __builtin_amdgcn_sched_barrier(0);
#pragma unroll
        for (int t = 0; t < 2; ++t)
#pragma unroll
            for (int q = 0; q < 2; ++q) { f32x4 acc = (f32x4){0.f, 0.f, 0.f, 0.f};
#pragma unroll
                for (int s = 0; s < 8; ++s) acc = __builtin_amdgcn_mfma_f32_16x16x32_bf16(wf[q][s], of[t][s], acc, 0, 0, 0);
                u32x2 w; w.x = pk2(acc[0], acc[1]); w.y = pk2(acc[2], acc[3]);
                *(u32x2*)(MIX1 + (size_t)(16 * (mt0 + t) + r) * DM + 1024 + 128 * h + 16 * (2 * np + q) + 4 * g) = w; }
        __builtin_amdgcn_sched_barrier(0); }
}
__device__ __forceinline__ void uv_project(const Args& a, int u_begin, int u_end, int u_step, int lane) {
    asm volatile("" : "+v"(lane));
    const bf16* OBUF = (const bf16*)(a.ws + WS_OBUF); const bf16* WUVT = (const bf16*)(a.ws + WS_WUVT); bf16* MIX1 = (bf16*)(a.ws + WS_MIX1);
    const int r = lane & 15, g = lane >> 4;
    for (int u = u_begin; u < u_end; u += u_step) { const int h = u & 7, mt = u >> 3;
        bf16x8 of[8];
#pragma unroll
        for (int s = 0; s < 8; ++s) of[s] = *(const bf16x8*)(OBUF + (size_t)(16 * mt + r) * 2048 + 256 * h + 32 * s + 8 * g);
#pragma unroll
        for (int np = 0; np < 4; ++np) { bf16x8 wf[2][8];
#pragma unroll
            for (int q = 0; q < 2; ++q) { const bf16* wr = WUVT + ((size_t)((h * 8 + 2 * np + q) * 8) * 64 + lane) * 8;
#pragma unroll
                for (int s = 0; s < 8; ++s) wf[q][s] = *(const bf16x8*)(wr + 512 * s); }
            __builtin_amdgcn_sched_barrier(0);
#pragma unroll
            for (int q = 0; q < 2; ++q) { f32x4 acc = (f32x4){0.f, 0.f, 0.f, 0.f};
#pragma unroll
                for (int s = 0; s < 8; ++s) acc = __builtin_amdgcn_mfma_f32_16x16x32_bf16(wf[q][s], of[s], acc, 0, 0, 0);
                u32x2 w; w.x = pk2(acc[0], acc[1]); w.y = pk2(acc[2], acc[3]);
                *(u32x2*)(MIX1 + (size_t)(16 * mt + r) * DM + 1024 + 128 * h + 16 * (2 * np + q) + 4 * g) = w; }
            __builtin_amdgcn_sched_barrier(0); }
    }
}

#ifndef MK_SINGLE
#define MK_SINGLE 1
#endif
#ifndef J3_P3
#define J3_P3 4224
#endif
#ifndef PG8_SP2
#define PG8_SP2 true
#endif
#ifndef PG8_ALIGN
#define PG8_ALIGN true
#endif

__global__ void __launch_bounds__(512, 2) mk_fwd(Args a) {
    __builtin_assume(__builtin_amdgcn_workitem_id_y() == 0); __builtin_assume(__builtin_amdgcn_workitem_id_z() == 0);
    extern __shared__ __attribute__((aligned(16))) unsigned char lds_raw[];
    LAS unsigned char* lds = (LAS unsigned char*)lds_raw;
    cg::grid_group grid = cg::this_grid();
    const int tid = threadIdx.x, lane = tid & 63, wave = __builtin_amdgcn_readfirstlane(tid >> 6);
    const int G = gridDim.x, bx = blockIdx.x;
    const int gw = bx * 8 + wave, NGW = G * 8;
    unsigned char* ws = a.ws;
    const int lo = a.ph_lo, hi = a.ph_hi;
#define IN(k) (lo <= (k) && (k) < hi)
    volatile LAS unsigned* xst = (volatile LAS unsigned*)(lds + LDS_BYTES - 64);
    if (tid < 16) xst[tid] = 0u;
    __syncthreads();
    const bool fused = (hi - lo) > 1;
    XcdBarrier xbar; xbar.bar = (unsigned*)(a.ws + WS_BAR); xbar.x = 0; xbar.st = xst;
    if (fused) xbar = xcd_barrier_post((unsigned*)(a.ws + WS_BAR), xst);
#define SEAM(k) do { if (IN(k) && IN((k) + 1)) xcd_barrier(xbar); } while (0)
    if (lo < 0) grid.sync();
#ifndef PROBE_REP_MASK
#define PROBE_REP_MASK 0
#endif
#define REP(k) for (int rep_ = 0; rep_ <= ((PROBE_REP_MASK >> (k)) & 1); ++rep_)
#define RSYNC() do { if (rep_) grid.sync(); } while (0)
    bf16* XN = (bf16*)(ws + WS_XN); bf16* Zb = (bf16*)(ws + WS_Z); float* X1 = (float*)(ws + WS_X1); float* SSQ = (float*)(ws + WS_SSQ);

    if (IN(0)) { p0_prologue(a, lds, tid, lane, wave, G); }
    SEAM(0);
    if (IN(1)) { pg8::Gemm g{XN, (const bf16*)(ws + WS_WIN0), M, EVEN_IN, DM, DM, DM}; pg8::StaticOrder S; S.init(M, EVEN_IN, G, bx);
        pg8::EpiBf16 E{Zb, EVEN_IN, Zb, EVEN_IN, 1 << 30, 16, nullptr};
        pg8::gemm_phase<pg8::EpiBf16, PG8_ALIGN, PG8_SP2>(lds, g, S, E); }
    SEAM(1);
    if (IN(2)) {
        for (int it = bx; it < 512; it += G) prep_item<256, false>(a, lds, it, tid, lane, wave);
        sgu_stats_rows(a, gw, NGW, lane);
    }
    SEAM(2);
    if (IN(3)) {
        if (bx < 64) { if (!(a.flags & 1)) scan_item<256, false>(a, lds, bx, tid, lane, wave); }
        else { if (!(a.flags & 2)) { conv_set<1>(a, lds, tid, lane, wave, (bx - 64) * 8 + wave, (G - 64) * 8, (bx - 64) * 512 + tid, (G - 64) * 512);
                conv_set<3>(a, lds, tid, lane, wave, (bx - 64) * 8 + wave, (G - 64) * 8, (bx - 64) * 512 + tid, (G - 64) * 512, 0, J3_P3); }
            __syncthreads();
            for (int it = bx - 64; it < 256; it += G - 64) sgu_item(a, lds, it, tid, lane, wave); }
    }
    SEAM(3);
    if (IN(4)) postnorm_rows<false>(a, gw, NGW, lane);
    SEAM(4);
    if (IN(5)) { pg8::Gemm g{(const bf16*)(ws + WS_MIX0), (const bf16*)(ws + WS_WOUT0), M, DM, DM, DM, DM}; pg8::StaticOrder S; S.init(M, DM, G, bx);
        pg8::EpiRes E{a.in[I_X], X1, DM, XN, SSQ};
        pg8::gemm_phase<pg8::EpiRes, PG8_ALIGN, PG8_SP2>(lds, g, S, E); }
    SEAM(5);
    if (IN(6)) { pg8::Gemm g{XN, (const bf16*)(ws + WS_WGU0), M, 2 * FF, DM, DM, DM}; pg8::StaticOrder S; S.init(M, 2 * FF, G, bx);
        pg8::EpiSwiglu E{Zb, FF, SSQ};
        pg8::gemm_phase<pg8::EpiSwiglu, PG8_ALIGN, PG8_SP2>(lds, g, S, E); }
    SEAM(6);
    if (IN(7)) { pg8::Gemm g{Zb, (const bf16*)(ws + WS_WD0), M, DM, FF, FF, FF}; pg8::StaticOrder S; S.init(M, DM, G, bx);
        pg8::EpiRes E{X1, a.out, DM, XN, SSQ + M};
        pg8::gemm_phase<pg8::EpiRes, PG8_ALIGN, PG8_SP2>(lds, g, S, E); }
    SEAM(7);
    if (IN(8)) { pg8::Gemm g{XN, (const bf16*)(ws + WS_WIN1), M, ODD_PAD, DM, DM, DM}; pg8::StaticOrder S; S.init(M, ODD_PAD, G, bx);
        pg8::EpiBf16 E{Zb, ODD_PAD, Zb, ODD_PAD, 1 << 30, 1 << 30, SSQ + M};
        pg8::gemm_phase<pg8::EpiBf16, PG8_ALIGN, PG8_SP2>(lds, g, S, E); }
    SEAM(8);
    if (IN(9)) {
        for (int it = bx; it < 1024; it += G) prep_item<128, true>(a, lds, it, tid, lane, wave);
        kvn_rows(a, gw, NGW, lane);
        asm volatile("s_waitcnt vmcnt(0)" ::: "memory"); __syncthreads();
        pg8::Gemm g{Zb + Z1_CQ, (const bf16*)(ws + WS_WDSA), M, 3072, 384, ODD_PAD, 384}; pg8::StaticOrder S; S.init(M, 3072, G, bx);
        pg8::EpiBf16 E{(bf16*)(ws + WS_QRAW), 2048, (bf16*)(ws + WS_QI), 1024, 8, 1 << 30, nullptr};
        pg8::gemm_phase<pg8::EpiBf16, PG8_ALIGN, PG8_SP2>(lds, g, S, E);
    }
    SEAM(9);
    if (IN(10)) {
        if (bx < 64) { if (!(a.flags & 1)) scan_item<128, true>(a, lds, bx, tid, lane, wave); }
        else { if (!(a.flags & 2)) { conv_set<3>(a, lds, tid, lane, wave, (bx - 64) * 8 + wave, (G - 64) * 8, 0, 0, J3_P3, 1 << 30);
                conv_set<2>(a, lds, tid, lane, wave, (bx - 64) * 8 + wave, (G - 64) * 8, (bx - 64) * 512 + tid, (G - 64) * 512); } }
        { unsigned* qc = (unsigned*)(ws + WS_QCNT) + ((a.flags & 64) ? 16 : 0); LAS int* sh = (LAS int*)(lds + LDS_BYTES - 96);
          __syncthreads();
          for (;;) {
              if (tid == 0) sh[0] = (int)__hip_atomic_fetch_add(qc, 1u, __ATOMIC_RELAXED, __HIP_MEMORY_SCOPE_AGENT);
              __syncthreads();
              const int j = sh[0];
              __syncthreads();
              if (j >= 1024) break;
              const int c = 63 - (j >> 4), w16 = j & 15; const int grp = (w16 >> 3) * 512 + c * 8 + (w16 & 7);
              idx_group(a, lds, grp, tid, lane, wave); } }
    }
    SEAM(10);
    if (IN(12)) {
        postnorm_rows<true>(a, gw, NGW, lane);
        { int qb, qe;
          if (G == 256) { const int x = bx & 7, j = bx >> 3; qb = (x & 1) * SEQ + 32 * ((x >> 1) * 32 + j); qe = qb + 32; }
          else { const int per = (M + G - 1) / G; qb = bx * per; qe = (qb + per < M) ? qb + per : M; }
          attn_queries(a, lds, qb, qe, tid, lane, wave);
          if (G == 256) { asm volatile("s_waitcnt vmcnt(0)" ::: "memory"); __syncthreads(); uv_project_pair(a, qb >> 4, wave, lane); } }
    }
    SEAM(12);
    if (IN(13)) { if (G != 256) uv_project(a, gw, (M / 16) * 8, NGW, lane); }
    if (G != 256) SEAM(13);
    if (IN(14)) { pg8::Gemm g{(const bf16*)(ws + WS_MIX1), (const bf16*)(ws + WS_WOUT1), M, DM, DM, DM, DM}; pg8::StaticOrder S; S.init(M, DM, G, bx);
        pg8::EpiRes E{a.out, X1, DM, XN, SSQ + 2 * M};
        pg8::gemm_phase<pg8::EpiRes, PG8_ALIGN, PG8_SP2>(lds, g, S, E); }
    SEAM(14);
    if (IN(15)) { pg8::Gemm g{XN, (const bf16*)(ws + WS_WGU1), M, 2 * FF, DM, DM, DM}; pg8::StaticOrder S; S.init(M, 2 * FF, G, bx);
        pg8::EpiSwiglu E{Zb, FF, SSQ + 2 * M};
        pg8::gemm_phase<pg8::EpiSwiglu, PG8_ALIGN, PG8_SP2>(lds, g, S, E); }
    SEAM(15);
    if (IN(16)) { pg8::Gemm g{Zb, (const bf16*)(ws + WS_WD1), M, DM, FF, FF, FF}; pg8::StaticOrder S; S.init(M, DM, G, bx);
        pg8::EpiRes E{X1, a.out, DM, nullptr, nullptr};
        pg8::gemm_phase<pg8::EpiRes, PG8_ALIGN, PG8_SP2>(lds, g, S, E); }
#undef IN
#undef SEAM
}

extern "C" void kernel_launch(void* const* d_in, const int* in_sizes, int n_in, void* d_out, int out_size, void* d_ws, size_t ws_size, hipStream_t stream) {
    static int grid = 0;
    if (grid == 0) {
        if (n_in != 23 || out_size != M * DM || ws_size < WS_END) { fprintf(stderr, "kernel_launch: unexpected shapes (n_in %d out %d ws %zu, need %zu)\n", n_in, out_size, ws_size, (size_t)WS_END); grid = -1; return; }
        int dev = 0, cus = 0, per_cu = 0;
        if (hipGetDevice(&dev) != hipSuccess || hipDeviceGetAttribute(&cus, hipDeviceAttributeMultiprocessorCount, dev) != hipSuccess) { grid = -1; return; }
        if (hipFuncSetAttribute((const void*)mk_fwd, hipFuncAttributeMaxDynamicSharedMemorySize, LDS_BYTES) != hipSuccess) { fprintf(stderr, "kernel_launch: hipFuncSetAttribute failed\n"); grid = -1; return; }
        if (hipOccupancyMaxActiveBlocksPerMultiprocessor(&per_cu, (const void*)mk_fwd, 512, LDS_BYTES) != hipSuccess || per_cu < 1) { fprintf(stderr, "kernel_launch: occupancy query says %d blocks per CU\n", per_cu); (void)hipGetLastError(); grid = -1; return; }
        grid = cus;
        if (grid != 256) fprintf(stderr, "kernel_launch: note: %d CUs (work split assumes 256)\n", grid);
    }
    if (grid < 0) return;
    Args a{};
    for (int i = 0; i < 23; ++i) a.in[i] = (const float*)d_in[i];
    a.out = (float*)d_out; a.ws = (unsigned char*)d_ws;
    if (hipMemsetAsync((unsigned char*)d_ws + WS_BAR, 0, BAR_BYTES, stream) != hipSuccess) { fprintf(stderr, "kernel_launch: hipMemsetAsync failed\n"); return; }
#if MK_SINGLE
    a.ph_lo = 0; a.ph_hi = NPHASES;
    void* args[] = {&a};
    hipError_t e = hipLaunchCooperativeKernel((const void*)mk_fwd, dim3(grid), dim3(512), args, LDS_BYTES, stream);
    if (e != hipSuccess) fprintf(stderr, "kernel_launch: cooperative launch failed: %s\n", hipGetErrorString(e));
#else
#ifndef PROBE_HOST_MASK
#define PROBE_HOST_MASK 0
#endif
#ifndef PROBE_REP_FLAGS
#define PROBE_REP_FLAGS 0
#endif
#ifndef PROBE_REP_COUNT
#define PROBE_REP_COUNT 1
#endif
    for (int p = 0; p < NPHASES; ++p) for (int rep = 0; rep <= (((PROBE_HOST_MASK >> p) & 1) ? PROBE_REP_COUNT : 0); ++rep) { a.ph_lo = p; a.ph_hi = p + 1; a.flags = rep ? PROBE_REP_FLAGS : 0; void* args[] = {&a};
        hipError_t e = hipLaunchCooperativeKernel((const void*)mk_fwd, dim3(grid), dim3(512), args, LDS_BYTES, stream);
        if (e != hipSuccess) { fprintf(stderr, "kernel_launch: launch %d failed: %s\n", p, hipGetErrorString(e)); break; } }
#endif
}
```
